# Optimizing an MI355X kernel written in HIP

```python
import math
import jax, jax.numpy as jnp
from jax import lax
import numpy as np

D_MODEL = 1024
BATCH = 8
SEQ = 2048
DEPTH = 1

N_MEM = 256
DA_HEADS = 8
DA_QK_DIM = 64
DA_V_DIM = 2 * DA_QK_DIM
DA_QK_WIDTH = DA_HEADS * 2 * DA_QK_DIM
DA_V_WIDTH = DA_HEADS * DA_V_DIM
LRU_WIDTH = D_MODEL
LRU_BLOCKS = 8
LRU_BLOCK = LRU_WIDTH // LRU_BLOCKS
CONV_WIDTH = 4
LRU_C = 8.0
CA_HEADS = 4
CA_HEAD_DIM = D_MODEL // CA_HEADS
CA_WIDTH = CA_HEADS * CA_HEAD_DIM
D_FF = 2816
MACARON_WEIGHT = 0.5
N_BRANCH = 3
Q_BLOCK = 128
EPS = 1e-6
IN_WIDTHS = (DA_QK_WIDTH, DA_QK_WIDTH, DA_V_WIDTH, LRU_WIDTH, LRU_WIDTH, CA_WIDTH)
D_IN = sum(IN_WIDTHS)
IN_SPLITS = tuple(int(v) for v in np.cumsum(IN_WIDTHS)[:-1])

kernel_name = 'hybrid_diffattn_rglru_memxattn_macaron'


def rmsnorm(x, g):
    xf = x.astype(jnp.float32)
    y = xf * lax.rsqrt(jnp.mean(xf * xf, axis=-1, keepdims=True) + EPS)
    return (y * g.astype(jnp.float32)).astype(x.dtype)


def swiglu_half_step(x, pre_g, w_gate, w_up, w_down, post_g):
    h = rmsnorm(x, pre_g)
    f = (jax.nn.silu(h @ w_gate) * (h @ w_up)) @ w_down
    return x + MACARON_WEIGHT * rmsnorm(f, post_g)


def alibi_slopes(n_heads):
    return jnp.exp2(-8.0 * jnp.arange(1, n_heads + 1, dtype=jnp.float32) / n_heads)


def diff_attention(q, k, v, lam, lam_init, head_g):
    B, S = q.shape[0], q.shape[1]
    q = q.transpose(0, 2, 3, 1, 4)
    k = k.transpose(0, 2, 3, 1, 4)
    v = v.transpose(0, 2, 1, 3)
    scale = DA_QK_DIM ** -0.5
    slopes = alibi_slopes(DA_HEADS)[:, None, None, None]
    outs = []
    for start in range(0, S, Q_BLOCK):
        end = start + Q_BLOCK
        qb = q[:, :, :, start:end]
        kb = k[:, :, :, :end]
        vb = v[:, :, :end]
        s = jnp.einsum('bhmqd,bhmkd->bhmqk', qb, kb).astype(jnp.float32) * scale
        dist = (jnp.arange(start, end)[:, None] - jnp.arange(end)[None, :]).astype(jnp.float32)
        s = jnp.where(dist >= 0.0, s - slopes * dist, -jnp.inf)
        p = jax.nn.softmax(s, axis=-1)
        a = p[:, :, 0] - lam * p[:, :, 1]
        outs.append(jnp.einsum('bhqk,bhkd->bhqd', a.astype(vb.dtype), vb))
    o = jnp.concatenate(outs, axis=2)
    o = rmsnorm(o, head_g) * (1.0 - lam_init)
    return o.transpose(0, 2, 1, 3).reshape(B, S, DA_V_WIDTH)


def rg_lru_branch(xr, yr, conv_w, conv_b, w_a, b_a, w_x, b_x, lam):
    B, S, W = xr.shape
    xp = jnp.pad(xr, ((0, 0), (CONV_WIDTH - 1, 0), (0, 0)))
    xc = conv_b + sum(xp[:, t:t + S] * conv_w[t] for t in range(CONV_WIDTH))
    xb = xc.reshape(B, S, LRU_BLOCKS, LRU_BLOCK)
    r = jax.nn.sigmoid(jnp.einsum('bsnc,ncd->bsnd', xb, w_a).reshape(B, S, W) + b_a)
    i = jax.nn.sigmoid(jnp.einsum('bsnc,ncd->bsnd', xb, w_x).reshape(B, S, W) + b_x)
    log_a = -LRU_C * r.astype(jnp.float32) * jax.nn.softplus(-lam.astype(jnp.float32))
    a = jnp.exp(log_a)
    u = jnp.sqrt(-jnp.expm1(2.0 * log_a)) * (i * xc).astype(jnp.float32)

    def combine(left, right):
        a1, b1 = left
        a2, b2 = right
        return a1 * a2, a2 * b1 + b2

    _, h = lax.associative_scan(combine, (a, u), axis=1)
    return h.astype(xr.dtype) * jax.nn.gelu(yr)


def memory_cross_attention(qc, mem_n, w_mem_kv):
    B, S = qc.shape[0], qc.shape[1]
    M = mem_n.shape[1]
    kv = mem_n @ w_mem_kv
    km, vm = jnp.split(kv, 2, axis=-1)
    q = qc.reshape(B, S, CA_HEADS, CA_HEAD_DIM)
    km = km.reshape(B, M, CA_HEADS, CA_HEAD_DIM)
    vm = vm.reshape(B, M, CA_HEADS, CA_HEAD_DIM)
    s = jnp.einsum('bshd,bmhd->bhsm', q, km).astype(jnp.float32) * (CA_HEAD_DIM ** -0.5)
    p = jax.nn.softmax(s, axis=-1)
    o = jnp.einsum('bhsm,bmhd->bshd', p.astype(vm.dtype), vm)
    return o.reshape(B, S, CA_WIDTH)


def setup_inputs(seed: int = 0) -> dict:
    key = jax.random.key(seed)
    ks = iter(jax.random.split(key, 40))

    def nrm(shape, scale):
        return jax.random.normal(next(ks), shape, jnp.float32) * scale

    def gain(shape):
        return 1.0 + nrm(shape, 0.02)

    L, D = DEPTH, D_MODEL
    d = {}
    d['x'] = nrm((BATCH, SEQ, D), 1.0)
    d['mem'] = nrm((BATCH, N_MEM, D), 1.0)
    d['ffn1_pre_g'] = gain((L, D))
    d['ffn1_w_gate'] = nrm((L, D, D_FF), D ** -0.5)
    d['ffn1_w_up'] = nrm((L, D, D_FF), D ** -0.5)
    d['ffn1_w_down'] = nrm((L, D_FF, D), D_FF ** -0.5)
    d['ffn1_post_g'] = gain((L, D))
    d['mix_pre_g'] = gain((L, D))
    d['w_in'] = nrm((L, D, D_IN), D ** -0.5)
    d['da_lambda_q1'] = nrm((L, DA_QK_DIM), 0.1)
    d['da_lambda_k1'] = nrm((L, DA_QK_DIM), 0.1)
    d['da_lambda_q2'] = nrm((L, DA_QK_DIM), 0.1)
    d['da_lambda_k2'] = nrm((L, DA_QK_DIM), 0.1)
    d['da_head_g'] = gain((L, DA_V_DIM))
    d['w_da_out'] = nrm((L, DA_V_WIDTH, D), DA_V_WIDTH ** -0.5)
    d['lru_conv_w'] = nrm((L, CONV_WIDTH, LRU_WIDTH), CONV_WIDTH ** -0.5)
    d['lru_conv_b'] = nrm((L, LRU_WIDTH), 0.01)
    d['lru_w_a'] = nrm((L, LRU_BLOCKS, LRU_BLOCK, LRU_BLOCK), LRU_BLOCK ** -0.5)
    d['lru_b_a'] = nrm((L, LRU_WIDTH), 0.01)
    d['lru_w_x'] = nrm((L, LRU_BLOCKS, LRU_BLOCK, LRU_BLOCK), LRU_BLOCK ** -0.5)
    d['lru_b_x'] = nrm((L, LRU_WIDTH), 0.01)
    a_max = jax.random.uniform(next(ks), (L, LRU_WIDTH), jnp.float32, 0.9, 0.999)
    s_root = a_max ** (1.0 / LRU_C)
    d['lru_lambda'] = jnp.log(s_root) - jnp.log1p(-s_root)
    d['w_lru_out'] = nrm((L, LRU_WIDTH, D), LRU_WIDTH ** -0.5)
    d['mem_g'] = gain((L, D))
    d['w_mem_kv'] = nrm((L, D, 2 * CA_WIDTH), D ** -0.5)
    d['w_ca_out'] = nrm((L, CA_WIDTH, D), CA_WIDTH ** -0.5)
    d['w_branch_gate'] = nrm((L, D, N_BRANCH * D), D ** -0.5)
    d['b_branch_gate'] = nrm((L, N_BRANCH * D), 0.01)
    d['w_mix_out'] = nrm((L, D, D), D ** -0.5)
    d['mix_post_g'] = gain((L, D))
    d['ffn2_pre_g'] = gain((L, D))
    d['ffn2_w_gate'] = nrm((L, D, D_FF), D ** -0.5)
    d['ffn2_w_up'] = nrm((L, D, D_FF), D ** -0.5)
    d['ffn2_w_down'] = nrm((L, D_FF, D), D_FF ** -0.5)
    d['ffn2_post_g'] = gain((L, D))
    return d


def reference(x, mem, ffn1_pre_g, ffn1_w_gate, ffn1_w_up, ffn1_w_down, ffn1_post_g,
              mix_pre_g, w_in, da_lambda_q1, da_lambda_k1, da_lambda_q2, da_lambda_k2,
              da_head_g, w_da_out, lru_conv_w, lru_conv_b, lru_w_a, lru_b_a, lru_w_x,
              lru_b_x, lru_lambda, w_lru_out, mem_g, w_mem_kv, w_ca_out, w_branch_gate,
              b_branch_gate, w_mix_out, mix_post_g, ffn2_pre_g, ffn2_w_gate, ffn2_w_up,
              ffn2_w_down, ffn2_post_g):
    B, S, D = x.shape
    for l in range(DEPTH):
        x = swiglu_half_step(x, ffn1_pre_g[l], ffn1_w_gate[l], ffn1_w_up[l], ffn1_w_down[l], ffn1_post_g[l])

        h = rmsnorm(x, mix_pre_g[l])
        proj = h @ w_in[l]
        q_da, k_da, v_da, x_lru, y_lru, q_ca = jnp.split(proj, IN_SPLITS, axis=-1)

        lam_init = 0.8 - 0.6 * math.exp(-0.3 * l)
        lam = (jnp.exp(jnp.sum(da_lambda_q1[l].astype(jnp.float32) * da_lambda_k1[l].astype(jnp.float32)))
               - jnp.exp(jnp.sum(da_lambda_q2[l].astype(jnp.float32) * da_lambda_k2[l].astype(jnp.float32)))
               + lam_init)
        o_da = diff_attention(q_da.reshape(B, S, DA_HEADS, 2, DA_QK_DIM),
                              k_da.reshape(B, S, DA_HEADS, 2, DA_QK_DIM),
                              v_da.reshape(B, S, DA_HEADS, DA_V_DIM),
                              lam, lam_init, da_head_g[l])
        y_da = o_da @ w_da_out[l]

        o_lru = rg_lru_branch(x_lru, y_lru, lru_conv_w[l], lru_conv_b[l], lru_w_a[l], lru_b_a[l],
                              lru_w_x[l], lru_b_x[l], lru_lambda[l])
        y_lru_out = o_lru @ w_lru_out[l]

        o_ca = memory_cross_attention(q_ca, rmsnorm(mem, mem_g[l]), w_mem_kv[l])
        y_ca = o_ca @ w_ca_out[l]

        gates = jax.nn.sigmoid(h @ w_branch_gate[l] + b_branch_gate[l]).reshape(B, S, N_BRANCH, D)
        merged = gates[:, :, 0] * y_da + gates[:, :, 1] * y_lru_out + gates[:, :, 2] * y_ca
        x = x + rmsnorm(merged @ w_mix_out[l], mix_post_g[l])

        x = swiglu_half_step(x, ffn2_pre_g[l], ffn2_w_gate[l], ffn2_w_up[l], ffn2_w_down[l], ffn2_post_g[l])
    return x
```

```cpp
#include <hip/hip_runtime.h>
#include <hip/hip_cooperative_groups.h>
#include <cstdio>
#include <cstdint>
namespace cg = cooperative_groups;

#define LAS __attribute__((address_space(3)))
typedef unsigned short bf16_t;
typedef short bf16x8 __attribute__((ext_vector_type(8)));
typedef short s16x4 __attribute__((ext_vector_type(4)));
typedef float f32x4 __attribute__((ext_vector_type(4)));
typedef float f32x2 __attribute__((ext_vector_type(2)));
typedef unsigned u32x4 __attribute__((ext_vector_type(4)));
typedef unsigned u32x2 __attribute__((ext_vector_type(2)));

constexpr int T = 16384, D = 1024, SEQ = 2048, NB = 8, DFF = 2816, NMEM = 256;
constexpr float EPS = 1e-6f;
constexpr float LOG2E = 1.4426950408889634f;

constexpr size_t MiB = 1u << 20;
constexpr size_t WS_CTL = 0;
constexpr size_t WS_WLRU = 1 * MiB;
constexpr size_t WS_KVM = 2 * MiB;
constexpr size_t WS_MEMN = 10 * MiB;
constexpr size_t WS_WKV = 14 * MiB;
constexpr size_t WS_WIN = 18 * MiB;
constexpr size_t WS_W3 = 18 * MiB, WS_WBG = 24 * MiB;
constexpr size_t WS_WMIX = 30 * MiB;
constexpr size_t WS_H = 32 * MiB;
constexpr size_t WS_BIG = 64 * MiB;
constexpr size_t WS_WGU = 64 * MiB;
constexpr size_t WS_WD = 75 * MiB;
constexpr size_t WS_ACT1 = 84 * MiB;
constexpr size_t SLOT = 32 * MiB;
constexpr size_t WS_SQ = 64 * MiB, WS_SK = 96 * MiB, WS_SV = 128 * MiB, WS_SX = 160 * MiB, WS_SY = 192 * MiB, WS_SQC = 224 * MiB;
constexpr size_t WS_GSCR = 96 * MiB;
constexpr size_t WS_MERGED = 160 * MiB;
constexpr size_t WS_ACT2 = 160 * MiB;
constexpr size_t WS_XSLOT = 1 * MiB + 512 * 1024;
constexpr int CW_CNT = 8192;
constexpr size_t WS_END = 256 * MiB;

typedef __bf16 bf16x2_t __attribute__((ext_vector_type(2)));
__device__ __forceinline__ unsigned cvt_pk_bf16(float lo, float hi) { const f32x2 v = {lo, hi}; const bf16x2_t b = __builtin_convertvector(v, bf16x2_t); return __builtin_bit_cast(unsigned, b); }
__device__ __forceinline__ float bf_lo(unsigned u) { return __uint_as_float(u << 16); }
__device__ __forceinline__ float bf_hi(unsigned u) { return __uint_as_float(u & 0xffff0000u); }
__device__ __forceinline__ float bf2f(bf16_t v) { return __uint_as_float(((unsigned)v) << 16); }
__device__ __forceinline__ bf16_t f2bf(float f) { return (bf16_t)(cvt_pk_bf16(f, 0.f) & 0xffffu); }
__device__ __forceinline__ float fast_rcp(float x) { return __builtin_amdgcn_rcpf(x); }
__device__ __forceinline__ float fast_exp2(float x) { return __builtin_amdgcn_exp2f(x); }
__device__ __forceinline__ float sigmoidf_(float x) { return fast_rcp(1.f + fast_exp2(-x * LOG2E)); }
__device__ __forceinline__ float xmax16(float v) { auto r = __builtin_amdgcn_permlane16_swap(__float_as_uint(v), __float_as_uint(v), false, false); return fmaxf(__uint_as_float(r[0]), __uint_as_float(r[1])); }
__device__ __forceinline__ float xmax32(float v) { auto r = __builtin_amdgcn_permlane32_swap(__float_as_uint(v), __float_as_uint(v), false, false); return fmaxf(__uint_as_float(r[0]), __uint_as_float(r[1])); }
__device__ __forceinline__ float xsum16(float v) { auto r = __builtin_amdgcn_permlane16_swap(__float_as_uint(v), __float_as_uint(v), false, false); return __uint_as_float(r[0]) + __uint_as_float(r[1]); }
__device__ __forceinline__ float xsum32(float v) { auto r = __builtin_amdgcn_permlane32_swap(__float_as_uint(v), __float_as_uint(v), false, false); return __uint_as_float(r[0]) + __uint_as_float(r[1]); }
#define LDS_BARRIER() do { asm volatile("s_waitcnt lgkmcnt(0)" ::: "memory"); __builtin_amdgcn_s_barrier(); asm volatile("" ::: "memory"); } while (0)
__device__ __forceinline__ float wave_sum(float v) {
#pragma unroll
    for (int o = 1; o < 64; o <<= 1) v += __shfl_xor(v, o);
    return v;
}

namespace pg8 {
constexpr int BM = 256, BK = 64, HALF = 128, HTB = HALF * BK * 2, STAGE_BYTES = 8 * HTB, NXCD = 8, WGM = 8;
__host__ __device__ __forceinline__ int lds_byte(int r, int c) { const int st = (r >> 4) * 2 + (c >> 5), rr = r & 15, cc = c & 31, ob = rr * 64 + cc * 2; return st * 1024 + (ob ^ (((ob >> 9) & 1) << 5)); }
__host__ __device__ __forceinline__ void stage_rc(int b, int& R, int& C) { const int st = b / 1024, sb = b % 1024, swz = sb ^ (((sb >> 9) & 1) << 5); R = (st >> 1) * 16 + swz / 64; C = (st & 1) * 32 + (swz % 64) / 2; }
__host__ __device__ __forceinline__ int perm32(int rho) { const int n = rho >> 4, i = rho & 15; return 8 * (i >> 2) + 4 * n + (i & 3); }

struct Unit { int pm, pn, kind; };

__device__ __forceinline__ void tile_of(int L, int nM, int nN, int& pm, int& pn) {
    const int nwg = nM * nN;
    int wgid = L; { const int q = nwg / NXCD, r = nwg % NXCD, xcd = wgid % NXCD, off = wgid / NXCD; wgid = (xcd < r ? xcd * (q + 1) : r * (q + 1) + (xcd - r) * q) + off; }
    const int nig = WGM * nN, gid = wgid / nig, fm = gid * WGM, gsz = (nM - fm) < WGM ? (nM - fm) : WGM;
    pm = fm + ((wgid % nig) % gsz); pn = (wgid % nig) / gsz;
}

template <class Epi, class Sched>
__device__ __forceinline__ void gemm_phase(LAS unsigned char* lds, const int K, const Sched& S, const Epi& E) {
    int tid = threadIdx.x; asm volatile("" : "+v"(tid));
    const int wid = __builtin_amdgcn_readfirstlane(tid >> 6), lane = tid & 63, wr = wid >> 2, wc = wid & 3, fr = lane & 15, fq = lane >> 4;
    const int nt = K / BK;
    unsigned voffA[2], voffB[2];
#pragma unroll
    for (int i = 0; i < 2; ++i) { int R, C; stage_rc(tid * 16 + i * 8192, R, C); const int Rb = Epi::PERM ? ((R & ~31) + perm32(R & 31)) : R;
        voffA[i] = (unsigned)(R * K + C) * 2u; voffB[i] = (unsigned)(Rb * K + C) * 2u; }
    const size_t kstep = (size_t)(BK * 2);
    const size_t hstep = (size_t)HALF * K * 2;
    const unsigned ldsw = (unsigned)wid * 1024u;
    const int aoff = lds_byte(wr * 64 + fr, fq * 8), boff = lds_byte(wc * 32 + fr, fq * 8);
#define PG8_SA(b, h) (((b) * 2 + (h)) * HTB)
#define PG8_SB(b, h) ((4 + (b) * 2 + (h)) * HTB)
#define PG8_STAGE(bufoff, gbase, voff) do { _Pragma("unroll") for (int _i = 0; _i < 2; ++_i) \
        __builtin_amdgcn_global_load_lds((const unsigned*)((const char*)(gbase) + (voff)[_i]), (LAS unsigned*)(lds + (bufoff) + ldsw + _i * 8192), 16, 0, 0); } while (0)
#define PG8_LDA(dst, b, h) do { _Pragma("unroll") for (int m = 0; m < 4; ++m) _Pragma("unroll") for (int k = 0; k < 2; ++k) dst[m][k] = *(const LAS bf16x8*)(lds + PG8_SA(b, h) + aoff + m * 2048 + k * 1024); } while (0)
#define PG8_LDB(dst, b, h) do { _Pragma("unroll") for (int n = 0; n < 2; ++n) _Pragma("unroll") for (int k = 0; k < 2; ++k) dst[n][k] = *(const LAS bf16x8*)(lds + PG8_SB(b, h) + boff + n * 2048 + k * 1024); } while (0)
#define PG8_MMA(ai, bj, At, Bt) do { __builtin_amdgcn_s_setprio(1); _Pragma("unroll") for (int m = 0; m < 4; ++m) _Pragma("unroll") for (int n = 0; n < 2; ++n) _Pragma("unroll") for (int k = 0; k < 2; ++k) \
        acc[ai][bj][m][n] = __builtin_amdgcn_mfma_f32_16x16x32_bf16(Bt[n][k], At[m][k], acc[ai][bj][m][n], 0, 0, 0); __builtin_amdgcn_s_setprio(0); } while (0)
#define PG8_WAIT_V(n) asm volatile("s_waitcnt vmcnt(" #n ")" ::: "memory")
#define PG8_WAIT_L(n) asm volatile("s_waitcnt lgkmcnt(" #n ")" ::: "memory")
#define PG8_BAR __builtin_amdgcn_s_barrier()
#define PG8_SCHED __builtin_amdgcn_sched_barrier(0)
    Unit cur, nxt; int ui = 0;
    if (!S.next(0, cur)) return;
    f32x4 acc[2][2][4][2];
#pragma unroll
    for (int a = 0; a < 2; ++a)
#pragma unroll
        for (int b = 0; b < 2; ++b)
#pragma unroll
            for (int m = 0; m < 4; ++m)
#pragma unroll
                for (int n = 0; n < 2; ++n) acc[a][b][m][n] = (f32x4){0.f, 0.f, 0.f, 0.f};
    bf16x8 At[4][2], B0[2][2], B1[2][2];
    const char* cA = S.a_ptr(cur); const char* cB = S.b_ptr(cur);
    PG8_STAGE(PG8_SB(0, 0), cB, voffB); PG8_STAGE(PG8_SB(0, 1), cB + hstep, voffB); PG8_STAGE(PG8_SA(0, 0), cA, voffA); PG8_STAGE(PG8_SA(0, 1), cA + hstep, voffA);
    if (wr == 1) PG8_BAR;
    PG8_WAIT_V(2); PG8_BAR;
    PG8_STAGE(PG8_SB(1, 0), cB + kstep, voffB); PG8_STAGE(PG8_SA(1, 0), cA + kstep, voffA); PG8_STAGE(PG8_SB(1, 1), cB + hstep + kstep, voffB);
    PG8_WAIT_V(6); PG8_BAR;
    for (;;) {
        const bool has_next = S.next(ui + 1, nxt);
        const char* nA = has_next ? S.a_ptr(nxt) : cA; const char* nB = has_next ? S.b_ptr(nxt) : cB;
        for (int t = 0; t < nt; t += 2) {
            const bool last = (t == nt - 2);
            const char* a1 = cA + (size_t)(t + 1) * kstep;
            const char* a2 = last ? nA : cA + (size_t)(t + 2) * kstep; const char* b2 = last ? nB : cB + (size_t)(t + 2) * kstep;
            const char* a3 = a2 + kstep; const char* b3 = b2 + kstep;
            PG8_LDB(B0, 0, 0); PG8_LDB(B1, 0, 1); PG8_SCHED; PG8_LDA(At, 0, 0); PG8_STAGE(PG8_SA(1, 1), a1 + hstep, voffA);
            PG8_WAIT_V(8); PG8_WAIT_L(0); PG8_BAR; PG8_MMA(0, 0, At, B0); PG8_MMA(0, 1, At, B1); PG8_BAR; PG8_SCHED;
            PG8_LDA(At, 0, 1); PG8_STAGE(PG8_SB(0, 0), b2, voffB); PG8_STAGE(PG8_SB(0, 1), b2 + hstep, voffB); PG8_STAGE(PG8_SA(0, 0), a2, voffA);
            PG8_WAIT_V(8); PG8_WAIT_L(0); PG8_BAR; PG8_MMA(1, 0, At, B0); PG8_MMA(1, 1, At, B1); PG8_BAR; PG8_SCHED;
            PG8_LDB(B0, 1, 0); PG8_LDB(B1, 1, 1); PG8_SCHED; PG8_LDA(At, 1, 0); PG8_STAGE(PG8_SA(0, 1), a2 + hstep, voffA);
            PG8_WAIT_V(8); PG8_WAIT_L(0); PG8_BAR; PG8_MMA(0, 0, At, B0); PG8_MMA(0, 1, At, B1); PG8_BAR; PG8_SCHED;
            PG8_LDA(At, 1, 1); PG8_STAGE(PG8_SB(1, 0), b3, voffB); PG8_STAGE(PG8_SB(1, 1), b3 + hstep, voffB); PG8_STAGE(PG8_SA(1, 0), a3, voffA);
            PG8_WAIT_V(8); PG8_WAIT_L(0); PG8_BAR; PG8_MMA(1, 0, At, B0); PG8_MMA(1, 1, At, B1); PG8_BAR; PG8_SCHED;
        }
        if (wr == 0) PG8_BAR;
        if constexpr (!Epi::AFTER_DRAIN) E(acc, cur, wr, wc, fr, fq);
        if (!has_next) break;
#pragma unroll
        for (int a = 0; a < 2; ++a)
#pragma unroll
            for (int b = 0; b < 2; ++b)
#pragma unroll
                for (int m = 0; m < 4; ++m)
#pragma unroll
                    for (int n = 0; n < 2; ++n) acc[a][b][m][n] = (f32x4){0.f, 0.f, 0.f, 0.f};
        cur = nxt; cA = nA; cB = nB; ++ui;
        if (wr == 1) PG8_BAR;
    }
    PG8_WAIT_V(0);
    PG8_BAR;
    if constexpr (Epi::AFTER_DRAIN) E.fused(acc, cur, wr, wc, fr, fq, lds, wid, lane);
#undef PG8_SA
#undef PG8_SB
#undef PG8_STAGE
#undef PG8_LDA
#undef PG8_LDB
#undef PG8_MMA
#undef PG8_WAIT_V
#undef PG8_WAIT_L
#undef PG8_BAR
#undef PG8_SCHED
}

struct SchedPlain {
    const char* A; const char* Bt; int K, nM, nN, G, c;
    __device__ __forceinline__ bool next(int i, Unit& u) const { const long L = (long)i * G + c; if (L >= (long)nM * nN) return false; tile_of((int)L, nM, nN, u.pm, u.pn); u.kind = 0; return true; }
    __device__ __forceinline__ const char* a_ptr(const Unit& u) const { return A + (size_t)u.pm * BM * K * 2; }
    __device__ __forceinline__ const char* b_ptr(const Unit& u) const { return Bt + (size_t)u.pn * BM * K * 2; }
};
struct SchedTwo {
    const char* A0; const char* B0; const char* A1; const char* B1; int K, nM0, nN0, nM1, nN1, G, c;
    __device__ __forceinline__ bool next(int i, Unit& u) const {
        const long L = (long)i * G + c; const int n0 = nM0 * nN0;
        if (L < n0) { tile_of((int)L, nM0, nN0, u.pm, u.pn); u.kind = 0; return true; }
        const int j = (int)(L - n0); if (j >= nM1 * nN1) return false;
        u.pm = j / nN1; u.pn = j % nN1; u.kind = 1; return true; }
    __device__ __forceinline__ const char* a_ptr(const Unit& u) const { return (u.kind ? A1 : A0) + (size_t)u.pm * BM * K * 2; }
    __device__ __forceinline__ const char* b_ptr(const Unit& u) const { return (u.kind ? B1 : B0) + (size_t)u.pn * BM * K * 2; }
};
struct SchedMerge {
    const char* H; const char* Wbg; const char* O0; const char* O1; const char* O2; const char* W3; int G, c;
    __device__ __forceinline__ bool next(int i, Unit& u) const { const int t = (i / 6) * G + c; if (t >= 256) return false; tile_of(t, 64, 4, u.pm, u.pn); u.kind = i % 6; return true; }
    __device__ __forceinline__ const char* a_ptr(const Unit& u) const { const int b = u.kind >> 1; const char* base = (u.kind & 1) ? (b == 0 ? O0 : (b == 1 ? O1 : O2)) : H; return base + (size_t)u.pm * BM * 1024 * 2; }
    __device__ __forceinline__ const char* b_ptr(const Unit& u) const { const int b = u.kind >> 1; const char* base = (u.kind & 1) ? W3 : Wbg; return base + ((size_t)b * 1024 + (size_t)u.pn * BM) * 1024 * 2; }
};

struct EpiSwigluKv {
    static constexpr bool AFTER_DRAIN = false;
    static constexpr bool PERM = true;
    bf16_t* act; bf16_t* O1; int ldc1;
    __device__ __forceinline__ void operator()(const f32x4 (&acc)[2][2][4][2], const Unit& u, int wr, int wc, int fr, int fq) const {
        const int row0 = u.pm * BM + wr * 64 + fr;
        if (u.kind == 0) {
            const int col0 = u.pn * 128 + wc * 32 + 8 * fq;
#pragma unroll
            for (int ai = 0; ai < 2; ++ai)
#pragma unroll
                for (int m = 0; m < 4; ++m) {
                    bf16_t* rowp = act + (size_t)(row0 + ai * HALF + m * 16) * DFF + col0;
                    float o[8];
#pragma unroll
                    for (int n = 0; n < 2; ++n)
#pragma unroll
                        for (int j = 0; j < 4; ++j) { const float g = acc[ai][0][m][n][j], up = acc[ai][1][m][n][j]; o[n * 4 + j] = g * sigmoidf_(g) * up; }
                    u32x4 w; w.x = cvt_pk_bf16(o[0], o[1]); w.y = cvt_pk_bf16(o[2], o[3]); w.z = cvt_pk_bf16(o[4], o[5]); w.w = cvt_pk_bf16(o[6], o[7]);
                    *(u32x4*)rowp = w;
                }
        } else {
            const int col0 = u.pn * BM + wc * 32 + 8 * fq;
#pragma unroll
            for (int ai = 0; ai < 2; ++ai)
#pragma unroll
                for (int m = 0; m < 4; ++m) {
                    bf16_t* rowp = O1 + (size_t)(row0 + ai * HALF + m * 16) * ldc1 + col0;
#pragma unroll
                    for (int bj = 0; bj < 2; ++bj) { const f32x4 v0 = acc[ai][bj][m][0], v1 = acc[ai][bj][m][1];
                        u32x4 w; w.x = cvt_pk_bf16(v0[0], v0[1]); w.y = cvt_pk_bf16(v0[2], v0[3]); w.z = cvt_pk_bf16(v1[0], v1[1]); w.w = cvt_pk_bf16(v1[2], v1[3]);
                        *(u32x4*)(rowp + bj * HALF) = w; }
                }
        }
    }
};
struct EpiSplitBf16 {
    static constexpr bool AFTER_DRAIN = false;
    static constexpr bool PERM = true;
    bf16_t* O; size_t split_stride;
    __device__ __forceinline__ void operator()(const f32x4 (&acc)[2][2][4][2], const Unit& u, int wr, int wc, int fr, int fq) const {
        const int row0 = u.pm * BM + wr * 64 + fr; int colt = u.pn * BM; const int t = colt >> 10; colt &= 1023;
        bf16_t* base = O + (size_t)t * split_stride; const int col0 = colt + wc * 32 + 8 * fq;
#pragma unroll
        for (int ai = 0; ai < 2; ++ai)
#pragma unroll
            for (int m = 0; m < 4; ++m) {
                bf16_t* rowp = base + (size_t)(row0 + ai * HALF + m * 16) * 1024 + col0;
#pragma unroll
                for (int bj = 0; bj < 2; ++bj) { const f32x4 v0 = acc[ai][bj][m][0], v1 = acc[ai][bj][m][1];
                    u32x4 w; w.x = cvt_pk_bf16(v0[0], v0[1]); w.y = cvt_pk_bf16(v0[2], v0[3]); w.z = cvt_pk_bf16(v1[0], v1[1]); w.w = cvt_pk_bf16(v1[2], v1[3]);
                    *(u32x4*)(rowp + bj * HALF) = w; }
            }
    }
};
struct EpiMerge {
    static constexpr bool AFTER_DRAIN = false;
    static constexpr bool PERM = true;
    u32x4* gscr; const float* bias; bf16_t* merged;
    __device__ __forceinline__ void operator()(const f32x4 (&acc)[2][2][4][2], const Unit& u, int wr, int wc, int fr, int fq) const {
        const int b = u.kind >> 1; int tid = threadIdx.x; asm volatile("" : "+v"(tid));
        const int row0 = u.pm * BM + wr * 64 + fr, col0 = u.pn * BM + wc * 32 + 8 * fq;
        if ((u.kind & 1) == 0) {
#pragma unroll
            for (int bj = 0; bj < 2; ++bj) {
                const f32x4 b0 = *(const f32x4*)(bias + b * 1024 + col0 + bj * HALF), b1 = *(const f32x4*)(bias + b * 1024 + col0 + bj * HALF + 4);
#pragma unroll
                for (int ai = 0; ai < 2; ++ai)
#pragma unroll
                    for (int m = 0; m < 4; ++m) { const f32x4 v0 = acc[ai][bj][m][0] + b0, v1 = acc[ai][bj][m][1] + b1;
                        u32x4 w; w.x = cvt_pk_bf16(sigmoidf_(v0[0]), sigmoidf_(v0[1])); w.y = cvt_pk_bf16(sigmoidf_(v0[2]), sigmoidf_(v0[3]));
                        w.z = cvt_pk_bf16(sigmoidf_(v1[0]), sigmoidf_(v1[1])); w.w = cvt_pk_bf16(sigmoidf_(v1[2]), sigmoidf_(v1[3]));
                        gscr[((ai * 4 + m) * 2 + bj) * 512 + tid] = w; }
            }
        } else {
#pragma unroll
            for (int ai = 0; ai < 2; ++ai)
#pragma unroll
                for (int bj = 0; bj < 2; ++bj) {
                    u32x4 gw[4], old[4];
#pragma unroll
                    for (int m = 0; m < 4; ++m) gw[m] = gscr[((ai * 4 + m) * 2 + bj) * 512 + tid];
                    if (b != 0) {
#pragma unroll
                        for (int m = 0; m < 4; ++m) old[m] = *(const u32x4*)(merged + (size_t)(row0 + ai * HALF + m * 16) * 1024 + col0 + bj * HALF);
                    }
#pragma unroll
                    for (int m = 0; m < 4; ++m) {
                        const f32x4 v0 = acc[ai][bj][m][0], v1 = acc[ai][bj][m][1];
                        float o[8];
                        o[0] = bf_lo(gw[m].x) * v0[0]; o[1] = bf_hi(gw[m].x) * v0[1]; o[2] = bf_lo(gw[m].y) * v0[2]; o[3] = bf_hi(gw[m].y) * v0[3];
                        o[4] = bf_lo(gw[m].z) * v1[0]; o[5] = bf_hi(gw[m].z) * v1[1]; o[6] = bf_lo(gw[m].w) * v1[2]; o[7] = bf_hi(gw[m].w) * v1[3];
                        if (b != 0) {
                            o[0] += bf_lo(old[m].x); o[1] += bf_hi(old[m].x); o[2] += bf_lo(old[m].y); o[3] += bf_hi(old[m].y);
                            o[4] += bf_lo(old[m].z); o[5] += bf_hi(old[m].z); o[6] += bf_lo(old[m].w); o[7] += bf_hi(old[m].w); }
                        u32x4 w; w.x = cvt_pk_bf16(o[0], o[1]); w.y = cvt_pk_bf16(o[2], o[3]); w.z = cvt_pk_bf16(o[4], o[5]); w.w = cvt_pk_bf16(o[6], o[7]);
                        *(u32x4*)(merged + (size_t)(row0 + ai * HALF + m * 16) * 1024 + col0 + bj * HALF) = w;
                    }
                    asm volatile("" ::: "memory");
                }
        }
    }
};

struct RmsExchange {
    unsigned* xbuf;
    unsigned* cnt;
    unsigned* tmo;
    __device__ __forceinline__ void run(const f32x4 (&v)[2][2][4][2], const Unit& u, int wr, int wc, int fr, int fq, LAS unsigned char* lds, int wid, int lane) const {
        LAS float* P = (LAS float*)lds; LAS float* S = (LAS float*)(lds + 8192);
#pragma unroll
        for (int ai = 0; ai < 2; ++ai)
#pragma unroll
            for (int m = 0; m < 4; ++m) {
                float q = 0.f;
#pragma unroll
                for (int bj = 0; bj < 2; ++bj)
#pragma unroll
                    for (int n = 0; n < 2; ++n) { const f32x4 x = v[ai][bj][m][n]; q += (x[0] * x[0] + x[1] * x[1]) + (x[2] * x[2] + x[3] * x[3]); }
                q = xsum32(xsum16(q));
                if (fq == 0) P[(ai * HALF + wr * 64 + m * 16 + fr) * 4 + wc] = q;
            }
        asm volatile("s_waitcnt lgkmcnt(0)" ::: "memory"); __builtin_amdgcn_s_barrier(); asm volatile("" ::: "memory");
        const int row = wid * 32 + (lane & 31);
        if (lane < 32) {
            const float t = (P[row * 4 + 0] + P[row * 4 + 1]) + (P[row * 4 + 2] + P[row * 4 + 3]);
            __hip_atomic_store(xbuf + ((size_t)(u.pm * BM + row) * 4 + u.pn), __float_as_uint(t), __ATOMIC_RELAXED, __HIP_MEMORY_SCOPE_AGENT);
        }
        asm volatile("s_waitcnt vmcnt(0)" ::: "memory");
        if (lane == 0) __hip_atomic_fetch_add(cnt + 64 * u.pm, 1u, __ATOMIC_RELAXED, __HIP_MEMORY_SCOPE_AGENT);
        if (wid == 0) {
            unsigned sp = 0u;
            for (;;) {
                if ((unsigned)__builtin_amdgcn_readfirstlane(__hip_atomic_load(cnt + 64 * u.pm, __ATOMIC_RELAXED, __HIP_MEMORY_SCOPE_AGENT)) >= 32u) break;
                if (++sp > (1u << 20)) { if (lane == 0) __hip_atomic_store(tmo, 1u, __ATOMIC_RELAXED, __HIP_MEMORY_SCOPE_AGENT); break; }
                __builtin_amdgcn_s_sleep(2);
            }
            __builtin_amdgcn_fence(__ATOMIC_ACQUIRE, "agent");
        }
        asm volatile("s_waitcnt vmcnt(0) lgkmcnt(0)" ::: "memory"); __builtin_amdgcn_s_barrier(); asm volatile("" ::: "memory");
        if (lane < 32) {
            const unsigned* slot = xbuf + (size_t)(u.pm * BM + row) * 4; float t = 0.f;
#pragma unroll
            for (int p = 0; p < 4; ++p) t += __uint_as_float(__hip_atomic_load(slot + p, __ATOMIC_RELAXED, __HIP_MEMORY_SCOPE_AGENT));
            S[row] = 1.0f / sqrtf(t * (1.f / 1024.f) + 1e-6f);
        }
        asm volatile("s_waitcnt lgkmcnt(0)" ::: "memory"); __builtin_amdgcn_s_barrier(); asm volatile("" ::: "memory");
    }
};
template <bool HAS_H> struct EpiRmsRes {
    static constexpr bool PERM = false, AFTER_DRAIN = true;
    const float* base; float* out; bf16_t* hb; const float* gpost; const float* gpre; float wgt; RmsExchange st1, st2;
    __device__ __forceinline__ void operator()(const f32x4 (&)[2][2][4][2], const Unit&, int, int, int, int) const {}
    __device__ __forceinline__ void fused(f32x4 (&acc)[2][2][4][2], const Unit& u, int wr, int wc, int fr, int fq, LAS unsigned char* lds, int wid, int lane) const {
        const LAS float* S = (const LAS float*)(lds + 8192);
        const int col0 = u.pn * BM + wc * 32 + 4 * fq;
        f32x4 pre[4][2][2];
#pragma unroll
        for (int m = 0; m < 4; ++m) { const size_t off = (size_t)(u.pm * BM + wr * 64 + m * 16 + fr) * 1024 + col0;
#pragma unroll
            for (int bj = 0; bj < 2; ++bj)
#pragma unroll
                for (int n = 0; n < 2; ++n) pre[m][bj][n] = *(const f32x4*)(base + off + bj * HALF + n * 16); }
        st1.run(acc, u, wr, wc, fr, fq, lds, wid, lane);
        {
            f32x4 gp[2][2];
#pragma unroll
            for (int bj = 0; bj < 2; ++bj)
#pragma unroll
                for (int n = 0; n < 2; ++n) gp[bj][n] = *(const f32x4*)(gpost + col0 + bj * HALF + n * 16);
#pragma unroll
            for (int ai = 0; ai < 2; ++ai)
#pragma unroll
                for (int m = 0; m < 4; ++m) { const int r = ai * HALF + wr * 64 + m * 16 + fr; const float rs = S[r] * wgt;
#pragma unroll
                    for (int bj = 0; bj < 2; ++bj)
#pragma unroll
                        for (int n = 0; n < 2; ++n) acc[ai][bj][m][n] = pre[m][bj][n] + acc[ai][bj][m][n] * rs * gp[bj][n];
                    asm volatile("" : "+v"(acc[ai][0][m][0]), "+v"(acc[ai][0][m][1]), "+v"(acc[ai][1][m][0]), "+v"(acc[ai][1][m][1]));
                    if (ai == 0) {
                        const size_t off2 = (size_t)(u.pm * BM + HALF + wr * 64 + m * 16 + fr) * 1024 + col0;
#pragma unroll
                        for (int bj = 0; bj < 2; ++bj)
#pragma unroll
                            for (int n = 0; n < 2; ++n) pre[m][bj][n] = *(const f32x4*)(base + off2 + bj * HALF + n * 16);
                    }
                }
        }
        if (HAS_H) st2.run(acc, u, wr, wc, fr, fq, lds, wid, lane);
        f32x4 gq[2][2];
        if (HAS_H) {
#pragma unroll
            for (int bj = 0; bj < 2; ++bj)
#pragma unroll
                for (int n = 0; n < 2; ++n) gq[bj][n] = *(const f32x4*)(gpre + col0 + bj * HALF + n * 16);
        }
#pragma unroll
        for (int ai = 0; ai < 2; ++ai)
#pragma unroll
            for (int m = 0; m < 4; ++m) { const int r = ai * HALF + wr * 64 + m * 16 + fr; const float rs2 = HAS_H ? S[r] : 0.f; const size_t off = (size_t)(u.pm * BM + r) * 1024 + col0;
#pragma unroll
                for (int bj = 0; bj < 2; ++bj) {
#pragma unroll
                    for (int n = 0; n < 2; ++n) *(f32x4*)(out + off + bj * HALF + n * 16) = acc[ai][bj][m][n];
                    if (HAS_H) {
                        const f32x4 oa = acc[ai][bj][m][0] * rs2 * gq[bj][0], ob = acc[ai][bj][m][1] * rs2 * gq[bj][1];
                        const unsigned ax = cvt_pk_bf16(oa[0], oa[1]), ay = cvt_pk_bf16(oa[2], oa[3]), bx_ = cvt_pk_bf16(ob[0], ob[1]), by_ = cvt_pk_bf16(ob[2], ob[3]);
                        const auto sx = __builtin_amdgcn_permlane16_swap(ax, bx_, false, false), sy = __builtin_amdgcn_permlane16_swap(ay, by_, false, false);
                        u32x4 w; w.x = sx[0]; w.y = sy[0]; w.z = sx[1]; w.w = sy[1];
                        *(u32x4*)(hb + (size_t)(u.pm * BM + r) * 1024 + u.pn * BM + wc * 32 + bj * HALF + 16 * (fq & 1) + 8 * (fq >> 1)) = w; }
                }
                asm volatile("" ::: "memory"); }
    }
};
}

__device__ __forceinline__ void transpose_item(const float* W, int K, int N, bf16_t* WT, int mode, int row_off, LAS float* scr, int item, int lane) {
    const int nblk = N / 32, kb = item / nblk, nb = item % nblk, k0 = 64 * kb, n0 = 32 * nb;
    { f32x4 v[8];
#pragma unroll
        for (int i = 0; i < 8; ++i) v[i] = *(const f32x4*)(W + (size_t)(k0 + 8 * i + (lane >> 3)) * N + n0 + 4 * (lane & 7));
#pragma unroll
        for (int i = 0; i < 8; ++i) { LAS float* d = scr + (8 * i + (lane >> 3)) * 33 + 4 * (lane & 7); d[0] = v[i].x; d[1] = v[i].y; d[2] = v[i].z; d[3] = v[i].w; } }
    asm volatile("s_waitcnt lgkmcnt(0)" ::: "memory");
    const int c = lane & 7;
    const int drow0 = (mode == 0) ? (row_off + n0) : ((n0 >> 7) * 256 + row_off + (n0 & 127));
#pragma unroll
    for (int j = 0; j < 4; ++j) { const int n = (lane >> 3) + 8 * j; const LAS float* s = scr + (8 * c) * 33 + n;
        u32x4 o; o.x = cvt_pk_bf16(s[0 * 33], s[1 * 33]); o.y = cvt_pk_bf16(s[2 * 33], s[3 * 33]); o.z = cvt_pk_bf16(s[4 * 33], s[5 * 33]); o.w = cvt_pk_bf16(s[6 * 33], s[7 * 33]);
        *(u32x4*)(WT + (size_t)(drow0 + n) * K + k0 + 8 * c) = o; }
    asm volatile("s_waitcnt lgkmcnt(0)" ::: "memory");
}

__device__ __forceinline__ void rms_row_to_bf16(const float* xrow, const float* g, bf16_t* orow, int lane) {
    const f32x4* xr = (const f32x4*)xrow + lane; const f32x4* gr = (const f32x4*)g + lane;
    f32x4 v[4]; float s = 0.f;
#pragma unroll
    for (int j = 0; j < 4; ++j) { v[j] = xr[64 * j]; s += (v[j].x * v[j].x + v[j].y * v[j].y) + (v[j].z * v[j].z + v[j].w * v[j].w); }
    const float rs = 1.0f / sqrtf(wave_sum(s) * (1.f / 1024.f) + EPS);
    u32x2* o8 = (u32x2*)orow + lane;
#pragma unroll
    for (int j = 0; j < 4; ++j) { const f32x4 gg = gr[64 * j]; u32x2 w; w.x = cvt_pk_bf16(v[j].x * rs * gg.x, v[j].y * rs * gg.y); w.y = cvt_pk_bf16(v[j].z * rs * gg.z, v[j].w * rs * gg.w); o8[64 * j] = w; }
}
__device__ __forceinline__ void rms_row2_to_bf16(const float* xrow0, const float* xrow1, const float* g, bf16_t* orow0, bf16_t* orow1, int lane) {
    const f32x4* xa = (const f32x4*)xrow0 + lane; const f32x4* xb = (const f32x4*)xrow1 + lane; const f32x4* gr = (const f32x4*)g + lane;
    f32x4 va[4], vb[4], gg[4]; float sa = 0.f, sb = 0.f;
#pragma unroll
    for (int j = 0; j < 4; ++j) { va[j] = xa[64 * j]; vb[j] = xb[64 * j]; gg[j] = gr[64 * j]; }
#pragma unroll
    for (int j = 0; j < 4; ++j) { sa += (va[j].x * va[j].x + va[j].y * va[j].y) + (va[j].z * va[j].z + va[j].w * va[j].w); sb += (vb[j].x * vb[j].x + vb[j].y * vb[j].y) + (vb[j].z * vb[j].z + vb[j].w * vb[j].w); }
    const float ra = 1.0f / sqrtf(wave_sum(sa) * (1.f / 1024.f) + EPS), rb = 1.0f / sqrtf(wave_sum(sb) * (1.f / 1024.f) + EPS);
    u32x2* oa = (u32x2*)orow0 + lane; u32x2* ob = (u32x2*)orow1 + lane;
#pragma unroll
    for (int j = 0; j < 4; ++j) { u32x2 w; w.x = cvt_pk_bf16(va[j].x * ra * gg[j].x, va[j].y * ra * gg[j].y); w.y = cvt_pk_bf16(va[j].z * ra * gg[j].z, va[j].w * ra * gg[j].w); oa[64 * j] = w;
        u32x2 v; v.x = cvt_pk_bf16(vb[j].x * rb * gg[j].x, vb[j].y * rb * gg[j].y); v.y = cvt_pk_bf16(vb[j].z * rb * gg[j].z, vb[j].w * rb * gg[j].w); ob[64 * j] = v; }
}
template <int NMAPS, int DK, int DV, bool CAUSAL, bool STORE = true, bool ALIBI = CAUSAL>
__device__ __forceinline__ void attn_unit(LAS unsigned char* lds, const bf16_t* Qg, const bf16_t* Kg, int kpitch, const bf16_t* Vg, int vpitch, bf16_t* Og, int qpitch,
                                          int q0, int ntiles, float c1, float slope2, float lam, const float* head_g) {
    constexpr int KW = NMAPS * DK, KP = KW + 8, VP = DV + 16;
    constexpr int KCH = KW / 8, VCH = DV / 8, KLD = 64 * KCH / 512, VLD = 64 * VCH / 512;
    constexpr int NKS = DK / 32, NDT = DV / 16;
    constexpr int TILEB = 64 * KP * 2 + 64 * VP * 2;
    constexpr bool LATEW = (NMAPS == 1);
    static_assert(!LATEW || !CAUSAL, "late-write form has no skipped tiles");
    int tid = threadIdx.x; asm volatile("" : "+v"(tid));
    const int lane = tid & 63, wid = __builtin_amdgcn_readfirstlane(tid >> 6), qi = lane & 15, g = lane >> 4;
    bf16x8 qf[NMAPS][NKS];
    { const bf16_t* qrow = Qg + (size_t)(wid * 16 + qi) * qpitch;
#pragma unroll
      for (int m = 0; m < NMAPS; ++m)
#pragma unroll
          for (int ks = 0; ks < NKS; ++ks) qf[m][ks] = *(const bf16x8*)(qrow + m * DK + ks * 32 + g * 8); }
    f32x4 O[NMAPS][NDT]; float mrun[NMAPS], lrun[NMAPS];
#pragma unroll
    for (int m = 0; m < NMAPS; ++m) { mrun[m] = -INFINITY; lrun[m] = 0.f;
#pragma unroll
        for (int dt = 0; dt < NDT; ++dt) O[m][dt] = (f32x4){0.f, 0.f, 0.f, 0.f}; }
    u32x4 kreg[KLD], vreg[VLD];
#define ATT_LOADREGS(t) do { \
    _Pragma("unroll") for (int c_ = 0; c_ < KLD; ++c_) { const int idx_ = tid + c_ * 512, row_ = idx_ / KCH, ch_ = idx_ % KCH; kreg[c_] = *(const u32x4*)(Kg + (size_t)((t) * 64 + row_) * kpitch + ch_ * 8); } \
    _Pragma("unroll") for (int c_ = 0; c_ < VLD; ++c_) { const int idx_ = tid + c_ * 512, row_ = idx_ / VCH, ch_ = idx_ % VCH; vreg[c_] = *(const u32x4*)(Vg + (size_t)((t) * 64 + row_) * vpitch + ch_ * 8); } } while (0)
#define ATT_WRITELDS(Kw, Vw) do { \
    _Pragma("unroll") for (int c_ = 0; c_ < KLD; ++c_) { const int idx_ = tid + c_ * 512, row_ = idx_ / KCH, ch_ = idx_ % KCH; *(LAS u32x4*)(Kw + (row_ * KP + ch_ * 8) * 2) = kreg[c_]; } \
    _Pragma("unroll") for (int c_ = 0; c_ < VLD; ++c_) { const int idx_ = tid + c_ * 512, row_ = idx_ / VCH, ch_ = idx_ % VCH; *(LAS u32x4*)(Vw + (row_ * VP + ch_ * 8) * 2) = vreg[c_]; } } while (0)
#define ATT_TILE(i_) (CAUSAL ? (ntiles - 1 - (i_)) : (i_))
    ATT_LOADREGS(ATT_TILE(0));
    LDS_BARRIER();
    ATT_WRITELDS(lds, lds + 64 * KP * 2);
    if (!LATEW && ntiles > 1) ATT_LOADREGS(ATT_TILE(1));
    __syncthreads();
    const int qpos = q0 + wid * 16 + qi;
    const int q4 = qi >> 2, p4 = qi & 3;
    f32x4 kbv[4];
#pragma unroll
    for (int tt = 0; tt < 4; ++tt)
#pragma unroll
        for (int r = 0; r < 4; ++r) kbv[tt][r] = ALIBI ? slope2 * (float)(16 * tt + 4 * g + r) : 0.f;
    for (int ti = 0; ti < ntiles; ++ti) {
        const int t = ATT_TILE(ti);
        LAS unsigned char* Kl = lds + (ti & 1) * TILEB; LAS unsigned char* Vl = Kl + 64 * KP * 2;
        if (!LATEW) {
            if (ti + 1 < ntiles) { LAS unsigned char* Kn = lds + ((ti + 1) & 1) * TILEB; ATT_WRITELDS(Kn, Kn + 64 * KP * 2); }
            if (ti + 2 < ntiles) ATT_LOADREGS(ATT_TILE(ti + 2));
        } else if (ti + 1 < ntiles) ATT_LOADREGS(ATT_TILE(ti + 1));
        const int k0 = 64 * t;
        const bool skip = CAUSAL && (k0 > q0 + wid * 16 + 15);
        if (!skip) {
            f32x4 s[NMAPS][4];
#pragma unroll
            for (int m = 0; m < NMAPS; ++m)
#pragma unroll
                for (int tt = 0; tt < 4; ++tt) { f32x4 a = (f32x4){0.f, 0.f, 0.f, 0.f};
#pragma unroll
                    for (int ks = 0; ks < NKS; ++ks) { const bf16x8 kf = *(const LAS bf16x8*)(Kl + ((16 * tt + qi) * KP + m * DK + ks * 32 + g * 8) * 2);
                        a = __builtin_amdgcn_mfma_f32_16x16x32_bf16(kf, qf[m][ks], a, 0, 0, 0); }
                    s[m][tt] = a; if (NKS > 2) __builtin_amdgcn_sched_barrier(0); }
            const bool needmask = CAUSAL && (k0 + 63 > q0 + wid * 16);
            const float tb = ALIBI ? slope2 * (float)k0 : 0.f;
            float mxv[NMAPS];
#pragma unroll
            for (int m = 0; m < NMAPS; ++m) {
#pragma unroll
                for (int tt = 0; tt < 4; ++tt) { s[m][tt] = ALIBI ? (s[m][tt] * c1 + kbv[tt]) : (s[m][tt] * c1);
                    if (needmask) {
#pragma unroll
                        for (int r = 0; r < 4; ++r) { const int kpos = k0 + 16 * tt + 4 * g + r; if (kpos > qpos) s[m][tt][r] = -INFINITY; } } }
                float mx = fmaxf(fmaxf(s[m][0][0], s[m][0][1]), s[m][0][2]);
                mx = fmaxf(fmaxf(mx, s[m][0][3]), s[m][1][0]); mx = fmaxf(fmaxf(mx, s[m][1][1]), s[m][1][2]); mx = fmaxf(fmaxf(mx, s[m][1][3]), s[m][2][0]);
                mx = fmaxf(fmaxf(mx, s[m][2][1]), s[m][2][2]); mx = fmaxf(fmaxf(mx, s[m][2][3]), s[m][3][0]); mx = fmaxf(fmaxf(mx, s[m][3][1]), s[m][3][2]); mx = fmaxf(mx, s[m][3][3]);
                mxv[m] = xmax32(xmax16(mx)) + tb;
            }
            bool dead = ALIBI;
#pragma unroll
            for (int m = 0; m < NMAPS; ++m) dead = dead && (mxv[m] - mrun[m] < -126.f);
            if (!(ALIBI && __all(dead))) {
#pragma unroll
            for (int m = 0; m < NMAPS; ++m) {
                const float mcand = fmaxf(mrun[m], mxv[m]);
                const float mnew = (mcand - mrun[m] > 8.f) ? mcand : mrun[m];
                const float alpha = fast_exp2(mrun[m] - mnew); mrun[m] = mnew;
                const float sub = mnew - tb;
                f32x4 ps4 = (f32x4){0.f, 0.f, 0.f, 0.f}; const f32x4 nsub4 = (f32x4){-sub, -sub, -sub, -sub};
#pragma unroll
                for (int tt = 0; tt < 4; ++tt) { const f32x4 d = s[m][tt] + nsub4; f32x4 p; p[0] = fast_exp2(d[0]); p[1] = fast_exp2(d[1]); p[2] = fast_exp2(d[2]); p[3] = fast_exp2(d[3]); s[m][tt] = p; ps4 = ps4 + p; }
                lrun[m] = lrun[m] * alpha + ((ps4[0] + ps4[1]) + (ps4[2] + ps4[3]));
                if (__any(alpha != 1.f)) {
#pragma unroll
                    for (int dt = 0; dt < NDT; ++dt) O[m][dt] = O[m][dt] * alpha;
                }
            }
            if (LATEW && ti + 1 < ntiles) { LAS unsigned char* Kn = lds + ((ti + 1) & 1) * TILEB; ATT_WRITELDS(Kn, Kn + 64 * KP * 2); }
#pragma unroll
            for (int kk = 0; kk < 2; ++kk) {
                bf16x8 pf[NMAPS];
#pragma unroll
                for (int m = 0; m < NMAPS; ++m) { u32x4 w; w.x = cvt_pk_bf16(s[m][2 * kk][0], s[m][2 * kk][1]); w.y = cvt_pk_bf16(s[m][2 * kk][2], s[m][2 * kk][3]);
                    w.z = cvt_pk_bf16(s[m][2 * kk + 1][0], s[m][2 * kk + 1][1]); w.w = cvt_pk_bf16(s[m][2 * kk + 1][2], s[m][2 * kk + 1][3]); pf[m] = __builtin_bit_cast(bf16x8, w); }
#pragma unroll
                for (int dt = 0; dt < NDT; ++dt) {
                    LAS unsigned char* vp = Vl + ((32 * kk + 4 * g + q4) * VP + 16 * dt + 4 * p4) * 2;
                    const s16x4 lo = __builtin_bit_cast(s16x4, __builtin_amdgcn_ds_read_tr16_b64_v4i16((LAS s16x4*)vp));
                    const s16x4 hi = __builtin_bit_cast(s16x4, __builtin_amdgcn_ds_read_tr16_b64_v4i16((LAS s16x4*)(vp + 16 * VP * 2)));
                    const bf16x8 vf = (bf16x8){lo[0], lo[1], lo[2], lo[3], hi[0], hi[1], hi[2], hi[3]};
#pragma unroll
                    for (int m = 0; m < NMAPS; ++m) O[m][dt] = __builtin_amdgcn_mfma_f32_16x16x32_bf16(vf, pf[m], O[m][dt], 0, 0, 0);
                    if (NDT > 8 && (dt & 3) == 3) __builtin_amdgcn_sched_barrier(0);
                }
            }
            }
        }
        __syncthreads();
    }
#undef ATT_TILE
#undef ATT_LOADREGS
#undef ATT_WRITELDS
    float inv[NMAPS];
#pragma unroll
    for (int m = 0; m < NMAPS; ++m) { const float l = xsum32(xsum16(lrun[m])); inv[m] = 1.0f / l; }
    bf16_t* orow = Og + (size_t)(wid * 16 + qi) * qpitch + 4 * g;
    if (NMAPS == 2) {
        float ss = 0.f;
#pragma unroll
        for (int dt = 0; dt < NDT; ++dt)
#pragma unroll
            for (int r = 0; r < 4; ++r) { const float o = O[0][dt][r] * inv[0] - lam * (O[NMAPS - 1][dt][r] * inv[NMAPS - 1]); O[0][dt][r] = o; ss += o * o; }
        ss = xsum32(xsum16(ss));
        const float rn = 0.8f / sqrtf(ss * (1.f / (float)DV) + EPS);
        bf16_t* orow16 = Og + (size_t)(wid * 16 + qi) * qpitch + 16 * (g & 1) + 8 * (g >> 1);
#pragma unroll
        for (int dp = 0; dp < NDT; dp += 2) { const f32x4 ga = *(const f32x4*)(head_g + 16 * dp + 4 * g), gb = *(const f32x4*)(head_g + 16 * dp + 16 + 4 * g);
            const unsigned ax = cvt_pk_bf16(O[0][dp][0] * rn * ga.x, O[0][dp][1] * rn * ga.y), ay = cvt_pk_bf16(O[0][dp][2] * rn * ga.z, O[0][dp][3] * rn * ga.w);
            const unsigned bx = cvt_pk_bf16(O[0][dp + 1][0] * rn * gb.x, O[0][dp + 1][1] * rn * gb.y), by = cvt_pk_bf16(O[0][dp + 1][2] * rn * gb.z, O[0][dp + 1][3] * rn * gb.w);
            const auto sx = __builtin_amdgcn_permlane16_swap(ax, bx, false, false), sy = __builtin_amdgcn_permlane16_swap(ay, by, false, false);
            u32x4 w; w.x = sx[0]; w.y = sy[0]; w.z = sx[1]; w.w = sy[1];
            if (STORE) *(u32x4*)(orow16 + 16 * dp) = w; else asm volatile("" :: "v"(w.x), "v"(w.y), "v"(w.z), "v"(w.w)); }
    } else {
        bf16_t* orow16 = Og + (size_t)(wid * 16 + qi) * qpitch + 16 * (g & 1) + 8 * (g >> 1);
#pragma unroll
        for (int dp = 0; dp < NDT; dp += 2) {
            const unsigned ax = cvt_pk_bf16(O[0][dp][0] * inv[0], O[0][dp][1] * inv[0]), ay = cvt_pk_bf16(O[0][dp][2] * inv[0], O[0][dp][3] * inv[0]);
            const unsigned bx = cvt_pk_bf16(O[0][dp + 1][0] * inv[0], O[0][dp + 1][1] * inv[0]), by = cvt_pk_bf16(O[0][dp + 1][2] * inv[0], O[0][dp + 1][3] * inv[0]);
            const auto sx = __builtin_amdgcn_permlane16_swap(ax, bx, false, false), sy = __builtin_amdgcn_permlane16_swap(ay, by, false, false);
            u32x4 w; w.x = sx[0]; w.y = sy[0]; w.z = sx[1]; w.w = sy[1];
            if (STORE) *(u32x4*)(orow16 + 16 * dp) = w; else asm volatile("" :: "v"(w.x), "v"(w.y), "v"(w.z), "v"(w.w)); }
    }
}

__device__ __forceinline__ float gelu_tanh(float y) {
    const float z = 0.7978845608028654f * (y + 0.044715f * y * y * y);
    const float e = fast_exp2(2.f * z * LOG2E);
    const float th = 1.f - 2.f * fast_rcp(e + 1.f);
    return 0.5f * y * (1.f + th);
}
template <bool STORE>
__device__ __forceinline__ void lru_unit(LAS unsigned char* lds, int b, int n, const bf16_t* X, bf16_t* Y, const bf16_t* WT,
                                         const float* conv_w, const float* conv_b, const float* b_a, const float* b_x, const float* lam) {
    constexpr int XP = 136;
    LAS bf16_t* Xl = (LAS bf16_t*)lds; LAS bf16_t* Yl = Xl + 128 * XP;
    int tid = threadIdx.x; asm volatile("" : "+v"(tid));
    const int lane = tid & 63, wid = __builtin_amdgcn_readfirstlane(tid >> 6), li = lane & 15, g = lane >> 4;
    const int ch = tid & 15, rbase = tid >> 4;
    const float* cwl = conv_w + 128 * n + 8 * ch; const float* cbl = conv_b + 128 * n + 8 * ch;
    const int cl = 16 * wid + li, cg_ = 128 * n + cl;
    const float ba = b_a[cg_], bx = b_x[cg_];
    const float sp8l2 = 8.f * log1pf(expf(-lam[cg_])) * LOG2E;
    bf16x8 wa[4], wx[4];
#pragma unroll
    for (int ks = 0; ks < 4; ++ks) { wa[ks] = *(const bf16x8*)(WT + ((size_t)(0 * 8 + n) * 128 + cl) * 128 + 32 * ks + 8 * g);
                                     wx[ks] = *(const bf16x8*)(WT + ((size_t)(1 * 8 + n) * 128 + cl) * 128 + 32 * ks + 8 * g); }
    float hc = 0.f;
    LAS bf16_t* Xr = Yl + 128 * XP;
    u32x4 xr[5], yr[4];
#define LRU_LOAD(c_) do { \
    _Pragma("unroll") for (int k_ = 0; k_ < 5; ++k_) { const int id_ = tid + 512 * k_, row_ = id_ >> 4, chx_ = id_ & 15; const int trel_ = 128 * (c_) - 3 + row_; \
        xr[k_] = (id_ < 131 * 16 && trel_ >= 0) ? *(const u32x4*)(X + ((size_t)b * SEQ + trel_) * 1024 + 128 * n + 8 * chx_) : (u32x4){0u, 0u, 0u, 0u}; } \
    _Pragma("unroll") for (int p_ = 0; p_ < 4; ++p_) yr[p_] = *(const u32x4*)(Y + ((size_t)b * SEQ + 128 * (c_) + rbase + 32 * p_) * 1024 + 128 * n + 8 * ch); } while (0)
    LRU_LOAD(0);
    for (int chunk = 0; chunk < 16; ++chunk) {
        const size_t tok0 = (size_t)b * SEQ + 128 * chunk;
        __syncthreads();
#pragma unroll
        for (int k = 0; k < 5; ++k) { const int id = tid + 512 * k, row = id >> 4, chx = id & 15; if (id < 131 * 16) *(LAS u32x4*)(Xr + row * XP + 8 * chx) = xr[k]; }
#pragma unroll
        for (int p = 0; p < 4; ++p) *(LAS u32x4*)(Yl + (rbase + 32 * p) * XP + 8 * ch) = yr[p];
        __syncthreads();
        if (chunk + 1 < 16) LRU_LOAD(chunk + 1);
        float cw[4][8], cb[8];
        { const float* cwp = cwl; const float* cbp = cbl; asm volatile("" : "+v"(cwp), "+v"(cbp));
          const f32x4 b0 = *(const f32x4*)cbp, b1 = *(const f32x4*)(cbp + 4); cb[0] = b0.x; cb[1] = b0.y; cb[2] = b0.z; cb[3] = b0.w; cb[4] = b1.x; cb[5] = b1.y; cb[6] = b1.z; cb[7] = b1.w;
#pragma unroll
          for (int j = 0; j < 4; ++j) { const f32x4 w0 = *(const f32x4*)(cwp + j * 1024), w1 = *(const f32x4*)(cwp + j * 1024 + 4);
              cw[j][0] = w0.x; cw[j][1] = w0.y; cw[j][2] = w0.z; cw[j][3] = w0.w; cw[j][4] = w1.x; cw[j][5] = w1.y; cw[j][6] = w1.z; cw[j][7] = w1.w; } }
#pragma unroll
        for (int p = 0; p < 4; ++p) {
            const int row = rbase + 32 * p;
            float a[8];
#pragma unroll
            for (int e = 0; e < 8; ++e) a[e] = cb[e];
#pragma unroll
            for (int j = 0; j < 4; ++j) { const u32x4 v = *(const LAS u32x4*)(Xr + (row + j) * XP + 8 * ch);
                a[0] += cw[j][0] * bf_lo(v.x); a[1] += cw[j][1] * bf_hi(v.x); a[2] += cw[j][2] * bf_lo(v.y); a[3] += cw[j][3] * bf_hi(v.y);
                a[4] += cw[j][4] * bf_lo(v.z); a[5] += cw[j][5] * bf_hi(v.z); a[6] += cw[j][6] * bf_lo(v.w); a[7] += cw[j][7] * bf_hi(v.w); }
            u32x4 w; w.x = cvt_pk_bf16(a[0], a[1]); w.y = cvt_pk_bf16(a[2], a[3]); w.z = cvt_pk_bf16(a[4], a[5]); w.w = cvt_pk_bf16(a[6], a[7]);
            *(LAS u32x4*)(Xl + row * XP + 8 * ch) = w;
        }
        __syncthreads();
        {
            float pa[8][4], pb[8][4];
#pragma unroll
            for (int tt = 0; tt < 8; ++tt) {
                f32x4 da = (f32x4){0.f, 0.f, 0.f, 0.f}, dx = (f32x4){0.f, 0.f, 0.f, 0.f};
#pragma unroll
                for (int ks = 0; ks < 4; ++ks) { const bf16x8 af = *(const LAS bf16x8*)(Xl + (16 * tt + li) * XP + 32 * ks + 8 * g);
                    da = __builtin_amdgcn_mfma_f32_16x16x32_bf16(af, wa[ks], da, 0, 0, 0); dx = __builtin_amdgcn_mfma_f32_16x16x32_bf16(af, wx[ks], dx, 0, 0, 0); }
#pragma unroll
                for (int r = 0; r < 4; ++r) { const int tl = 16 * tt + 4 * g + r; const float xcv = bf2f(Xl[tl * XP + cl]);
                    const float rr = sigmoidf_(da[r] + ba), ii = sigmoidf_(dx[r] + bx);
                    const float a = fast_exp2(-sp8l2 * rr); const float u = __builtin_amdgcn_sqrtf(fmaxf(__builtin_fmaf(-a, a, 1.f), 0.f)) * (ii * xcv);
                    if (r == 0) { pa[tt][0] = a; pb[tt][0] = u; } else { pa[tt][r] = a * pa[tt][r - 1]; pb[tt][r] = a * pb[tt][r - 1] + u; } }
            }
            float ea[8], eb[8], Ta[8], Tb[8];
#pragma unroll
            for (int tt = 0; tt < 8; ++tt) {
                float sa = pa[tt][3], sb = pb[tt][3];
                { const float ta = __shfl_up(sa, 16), tb = __shfl_up(sb, 16); if (g >= 1) { sb = sa * tb + sb; sa = ta * sa; } }
                { const float ta = __shfl_up(sa, 32), tb = __shfl_up(sb, 32); if (g >= 2) { sb = sa * tb + sb; sa = ta * sa; } }
                float e0 = __shfl_up(sa, 16), e1 = __shfl_up(sb, 16); if (g == 0) { e0 = 1.f; e1 = 0.f; }
                ea[tt] = e0; eb[tt] = e1; Ta[tt] = __shfl(sa, 48 + li); Tb[tt] = __shfl(sb, 48 + li);
            }
#pragma unroll
            for (int tt = 0; tt < 8; ++tt) {
                const float hg = ea[tt] * hc + eb[tt];
                hc = Ta[tt] * hc + Tb[tt];
#pragma unroll
                for (int r = 0; r < 4; ++r) { const int tl = 16 * tt + 4 * g + r; const float h = pa[tt][r] * hg + pb[tt][r];
                    const float yv = bf2f(Yl[tl * XP + cl]); Yl[tl * XP + cl] = f2bf(h * gelu_tanh(yv)); }
            }
        }
        __syncthreads();
#pragma unroll
        for (int p = 0; p < 4; ++p) { const int row = rbase + 32 * p; const u32x4 ov = *(const LAS u32x4*)(Yl + row * XP + 8 * ch); if (STORE) *(u32x4*)(Y + (tok0 + row) * 1024 + 128 * n + 8 * ch) = ov; else asm volatile("" :: "v"(ov.x), "v"(ov.y), "v"(ov.z), "v"(ov.w)); }
    }
}


#define XB_TMO      128
#define XB_XCNT(j)  (256  + 64 * (j))
#define XB_XSUB(j)  (1280 + 64 * (j))
#define XB_XGEN(j)  (2304 + 64 * (j))
#define XB_TOP      3328
#define XB_TOPGEN   3392
#define XCD_BAR_WORDS 3456
#define XB_SPIN_CAP (1u << 18)
__device__ __forceinline__ unsigned xb_ld(unsigned* p)              { return __hip_atomic_load(p, __ATOMIC_RELAXED, __HIP_MEMORY_SCOPE_AGENT); }
__device__ __forceinline__ unsigned xb_add(unsigned* p, unsigned v) { return __hip_atomic_fetch_add(p, v, __ATOMIC_RELAXED, __HIP_MEMORY_SCOPE_AGENT); }
__device__ __forceinline__ unsigned xb_xcc_id() { return (unsigned)__builtin_amdgcn_s_getreg((3 << 11) | 20) & 0xFu; }
#define XB_SPIN(cond, bar) do { unsigned _sp = 0; while (cond) { __builtin_amdgcn_s_sleep(1); \
    if ((++_sp & 255u) == 0u) { if (xb_ld(&(bar)[XB_TMO])) break; if (_sp > XB_SPIN_CAP) { atomicAdd(&(bar)[XB_TMO], 1u); break; } } } } while (0)
struct XcdBarrier { unsigned* bar; unsigned x; volatile LAS unsigned* st; };
__device__ __forceinline__ XcdBarrier xcd_barrier_post(unsigned* bar, volatile LAS unsigned* st) {
    XcdBarrier b; b.bar = bar; b.x = xb_xcc_id(); b.st = st;
    if (threadIdx.x == 0) (void)xb_add(&bar[XB_XCNT(b.x)], 1u);
    return b;
}
__device__ __forceinline__ void xcd_barrier_complete(unsigned* bar, unsigned x, unsigned& nloc, unsigned& nx) {
    const unsigned G = gridDim.x * gridDim.y * gridDim.z;
    unsigned sum, cnt, mine, sp = 0u;
    for (;;) {
        sum = 0u; cnt = 0u; mine = 0u;
#pragma unroll
        for (unsigned j = 0; j < 16; ++j) { const unsigned c = xb_ld(&bar[XB_XCNT(j)]); sum += c; cnt += (c > 0u) ? 1u : 0u; mine = (j == x) ? c : mine; }
        if (sum == G) break;
        __builtin_amdgcn_s_sleep(1);
        if ((++sp & 255u) == 0u) { if (xb_ld(&bar[XB_TMO])) break; if (sp > XB_SPIN_CAP) { atomicAdd(&bar[XB_TMO], 1u); break; } }
    }
    nloc = mine > 0u ? mine : 1u; nx = cnt > 0u ? cnt : 1u;
}
__device__ __forceinline__ void xcd_barrier(const XcdBarrier& b) {
    asm volatile("s_waitcnt vmcnt(0)" ::: "memory");
    __syncthreads();
    if (threadIdx.x == 0) {
        unsigned* bar = b.bar;
        __builtin_amdgcn_s_waitcnt(0);
        unsigned nloc = b.st[0], nx = b.st[1];
        if (nloc == 0u) { xcd_barrier_complete(bar, b.x, nloc, nx); b.st[0] = nloc; b.st[1] = nx; }
        const unsigned old = xb_add(&bar[XB_XSUB(b.x)], 1u);
        const unsigned gen = old / nloc;
        if (old + 1u == (gen + 1u) * nloc) {
            __builtin_amdgcn_fence(__ATOMIC_RELEASE, "agent");
            asm volatile("s_waitcnt vmcnt(0)" ::: "memory");
            const unsigned og = xb_add(&bar[XB_TOP], 1u);
            const unsigned tg = og / nx;
            if (og + 1u == (tg + 1u) * nx) xb_add(&bar[XB_TOPGEN], 1u);
            else XB_SPIN(xb_ld(&bar[XB_TOPGEN]) == tg, bar);
            __builtin_amdgcn_fence(__ATOMIC_ACQUIRE, "agent");
            xb_add(&bar[XB_XGEN(b.x)], 1u);
            asm volatile("s_waitcnt vmcnt(0)" ::: "memory");
        } else {
            XB_SPIN(xb_ld(&bar[XB_XGEN(b.x)]) == gen, bar);
            __builtin_amdgcn_fence(__ATOMIC_ACQUIRE, "agent");
            asm volatile("s_waitcnt vmcnt(0)" ::: "memory");
        }
    }
    __syncthreads();
}
__device__ __forceinline__ const float* ldptr(LAS unsigned long long* PT, int i) { const unsigned long long v = PT[i];
    const unsigned lo = __builtin_amdgcn_readfirstlane((unsigned)v), hi = __builtin_amdgcn_readfirstlane((unsigned)(v >> 32)); return (const float*)(((unsigned long long)hi << 32) | lo); }
constexpr int NWAVES = 8;
constexpr int LDS_BYTES = 147456;
constexpr int MISC_OFF = 143360;
struct Args { const float* in[35]; float* out; unsigned char* ws; };

#define CONV(Wsrc, Kd, Nd, WTdst, mode, roff) { const int ni_ = ((Kd) / 64) * ((Nd) / 32); if (r >= 0) { if (r < ni_) { transpose_item((Wsrc), (Kd), (Nd), (WTdst), (mode), (roff), scr, r, lane); r = -1; } else r -= ni_; } }

__global__ void __launch_bounds__(NWAVES * 64) fwd_megakernel(Args args) {
    extern __shared__ __attribute__((aligned(16))) unsigned char lds_raw[];
    cg::grid_group grid = cg::this_grid();
    LAS unsigned char* lds = (LAS unsigned char*)lds_raw;
    volatile LAS unsigned* MISC = (volatile LAS unsigned*)(lds + MISC_OFF);
    const int wave = __builtin_amdgcn_readfirstlane((int)threadIdx.x >> 6);
    const int G = gridDim.x, bx = blockIdx.x;
    const int gw = bx * NWAVES + wave, NGW = G * NWAVES;
#define CG_SYNC() do { asm volatile("s_waitcnt vmcnt(0) lgkmcnt(0)" ::: "memory"); grid.sync(); \
        if (wave == 0) { __builtin_amdgcn_fence(__ATOMIC_ACQUIRE, "agent"); asm volatile("s_waitcnt vmcnt(0)" ::: "memory"); } __syncthreads(); } while (0)
#define GRID_SYNC() xcd_barrier(xbar)
#define FRESH() int tid = threadIdx.x; asm volatile("" : "+v"(tid)); const int lane = tid & 63; (void)lane
    LAS unsigned long long* PT = (LAS unsigned long long*)(lds + MISC_OFF + 64);
    unsigned* barw = (unsigned*)(args.ws + WS_CTL) + 1024;
    { FRESH();
    if (tid < 35) PT[tid] = (unsigned long long)args.in[tid];
    if (tid < 16) MISC[tid] = 0u;
    if (bx == 0) { for (int i = tid; i < XCD_BAR_WORDS; i += NWAVES * 64) __hip_atomic_store(barw + i, 0u, __ATOMIC_RELAXED, __HIP_MEMORY_SCOPE_AGENT);
        for (int i = tid; i < 5 * 64; i += NWAVES * 64) __hip_atomic_store((unsigned*)(args.ws + WS_CTL) + CW_CNT + (i / 64) * 4096 + 64 * (i % 64), 0u, __ATOMIC_RELAXED, __HIP_MEMORY_SCOPE_AGENT);
        if (tid == 0) __hip_atomic_store((unsigned*)(args.ws + WS_CTL) + 2, 0u, __ATOMIC_RELAXED, __HIP_MEMORY_SCOPE_AGENT); } }
    __syncthreads();
#define IN(i) ldptr(PT, (i))
    unsigned char* ws = args.ws;
    const float* x = args.in[0];
    float* out = args.out;
    bf16_t* Hb = (bf16_t*)(ws + WS_H);
    LAS float* scr = (LAS float*)(lds + wave * 16384);
    CG_SYNC();
    const XcdBarrier xbar = xcd_barrier_post(barw, MISC + 8);

    {
        FRESH();
        if (bx == 0 && tid == 0) { atomicExch((unsigned*)(ws + WS_CTL), 0u); atomicExch((unsigned*)(ws + WS_CTL) + 64, 0u); }
        constexpr int NIT = 2 * 1408 + 512 + 1024 + 16 * 8;
        for (int it = gw; it < NIT; it += NGW) {
            int r = it;
            CONV(IN(3), 1024, DFF, (bf16_t*)(ws + WS_WGU), 1, 0);
            CONV(IN(4), 1024, DFF, (bf16_t*)(ws + WS_WGU), 1, 128);
            CONV(IN(28), 1024, 1024, (bf16_t*)(ws + WS_WMIX), 0, 0);
            CONV(IN(24), 1024, 2048, (bf16_t*)(ws + WS_WKV), 0, 0);
            if (r >= 0) { const int mat = r >> 3, sub = r & 7; const float* src = (mat < 8 ? IN(17) + (size_t)mat * 16384 : IN(19) + (size_t)(mat - 8) * 16384);
              transpose_item(src, 128, 128, (bf16_t*)(ws + WS_WLRU) + (size_t)mat * 16384, 0, 0, scr, sub, lane); }
        }
        { int m = gw;
          for (; m + NGW < T; m += 2 * NGW) rms_row2_to_bf16(x + (size_t)m * D, x + (size_t)(m + NGW) * D, IN(2), Hb + (size_t)m * D, Hb + (size_t)(m + NGW) * D, lane);
          if (m < T) rms_row_to_bf16(x + (size_t)m * D, IN(2), Hb + (size_t)m * D, lane); }
        for (int m = gw; m < NB * NMEM; m += NGW) rms_row_to_bf16(IN(1) + (size_t)m * D, IN(23), (bf16_t*)(ws + WS_MEMN) + (size_t)m * D, lane);
    }
    GRID_SYNC();


    {
        pg8::SchedTwo S{(const char*)Hb, (const char*)(ws + WS_WGU), (const char*)(ws + WS_MEMN), (const char*)(ws + WS_WKV), 1024, 64, 22, 8, 8, G, bx};
        pg8::EpiSwigluKv E{(bf16_t*)(ws + WS_ACT1), (bf16_t*)(ws + WS_KVM), 2048};
        pg8::gemm_phase(lds, 1024, S, E);
        const int nfull = (64 * 22 + 64) % G;
        const int nhelp = (nfull == 0) ? G : G - nfull, hidx = (nfull == 0) ? bx : bx - nfull;
        if (hidx >= 0) {
            FRESH();
            constexpr int NIT = 1408 + 3072;
            for (int it = hidx * NWAVES + wave; it < NIT; it += nhelp * NWAVES) {
                int r = it;
                CONV(IN(5), DFF, 1024, (bf16_t*)(ws + WS_WD), 0, 0);
                if (r >= 0) transpose_item(IN(8), 1024, 6144, (bf16_t*)(ws + WS_WIN), 0, 0, scr, r, lane);
            }
        }
    }
    GRID_SYNC();
    {
        unsigned* ctl = (unsigned*)(ws + WS_CTL);
        pg8::SchedPlain S{(const char*)(ws + WS_ACT1), (const char*)(ws + WS_WD), DFF, 64, 4, G, bx};
        pg8::RmsExchange st1{(unsigned*)(ws + WS_XSLOT), ctl + CW_CNT + 0 * 4096, ctl + 2}, st2{(unsigned*)(ws + WS_XSLOT) + 65536, ctl + CW_CNT + 1 * 4096, ctl + 2};
        pg8::EpiRmsRes<true> E{x, out, Hb, IN(6), IN(7), 0.5f, st1, st2};
        pg8::gemm_phase(lds, DFF, S, E);
    }
    GRID_SYNC();
    {
        pg8::SchedPlain S{(const char*)Hb, (const char*)(ws + WS_WIN), 1024, 64, 24, G, bx};
        pg8::EpiSplitBf16 E{(bf16_t*)(ws + WS_SQ), (size_t)T * 1024};
        pg8::gemm_phase(lds, 1024, S, E);
    }
    GRID_SYNC();
    {
        FRESH();
        constexpr int NIT = 3 * 512 + 1536;
        for (int it = gw; it < NIT; it += NGW) {
            int r = it;
            CONV(IN(14), 1024, 1024, (bf16_t*)(ws + WS_W3), 0, 0);
            CONV(IN(22), 1024, 1024, (bf16_t*)(ws + WS_W3), 0, 1024);
            CONV(IN(25), 1024, 1024, (bf16_t*)(ws + WS_W3), 0, 2048);
            if (r >= 0) transpose_item(IN(26), 1024, 3072, (bf16_t*)(ws + WS_WBG), 0, 0, scr, r, lane);
        }
        float lamv;
        { float s1 = 0.f, s2 = 0.f;
          s1 = wave_sum(IN(9)[lane] * IN(10)[lane]); s2 = wave_sum(IN(11)[lane] * IN(12)[lane]);
          lamv = __uint_as_float(__builtin_amdgcn_readfirstlane(__float_as_uint(expf(s1) - expf(s2) + 0.2f))); }
        unsigned* ctr = (unsigned*)(ws + WS_CTL);
        constexpr int NU_LRU = 64, NU_DA = 1024, NU_CA = 512, NU = NU_LRU + NU_DA;
        for (;;) {
            LDS_BARRIER();
            if (threadIdx.x == 0) MISC[0] = atomicAdd(ctr, 1u);
            LDS_BARRIER();
            const unsigned uu = MISC[0];
            if (uu >= (unsigned)NU) break;
            const int u = (int)uu;
            if (u < NU_LRU) {
                lru_unit<true>(lds, u >> 3, u & 7, (const bf16_t*)(ws + WS_SX), (bf16_t*)(ws + WS_SY), (const bf16_t*)(ws + WS_WLRU), IN(15), IN(16), IN(18), IN(20), IN(21));
            } else {
                const int j = u - NU_LRU, qb = 15 - (j >> 6), bh = j & 63, b = bh >> 3, h = bh & 7;
                const size_t rowb = (size_t)b * SEQ;
                bf16_t* Q = (bf16_t*)(ws + WS_SQ) + (rowb + 128 * qb) * 1024 + h * 128;
                const bf16_t* Kp = (const bf16_t*)(ws + WS_SK) + rowb * 1024 + h * 128;
                const bf16_t* Vp = (const bf16_t*)(ws + WS_SV) + rowb * 1024 + h * 128;
                const float slope = exp2f(-(float)(h + 1));
                attn_unit<2, 64, 128, true>(lds, Q, Kp, 1024, Vp, 1024, Q, 1024, 128 * qb, 2 * (qb + 1), 0.125f * LOG2E, slope * LOG2E, lamv, IN(13));
            }
        }
        for (;;) {
            LDS_BARRIER();
            if (threadIdx.x == 0) MISC[0] = atomicAdd(ctr + 64, 1u);
            LDS_BARRIER();
            const unsigned uu = MISC[0];
            if (uu >= (unsigned)NU_CA) break;
            {
                const int j = (int)uu, qb = j >> 5, bh = j & 31, b = bh >> 2, h = bh & 3;
                bf16_t* Q = (bf16_t*)(ws + WS_SQC) + ((size_t)b * SEQ + 128 * qb) * 1024 + h * 256;
                const bf16_t* Kp = (const bf16_t*)(ws + WS_KVM) + (size_t)b * NMEM * 2048 + h * 256;
                const bf16_t* Vp = Kp + 1024;
                attn_unit<1, 256, 256, false>(lds, Q, Kp, 2048, Vp, 2048, Q, 1024, 0, 4, 0.0625f * LOG2E, 0.f, 0.f, IN(13));
            }
        }
    }
    GRID_SYNC();
    {
        pg8::SchedMerge S{(const char*)Hb, (const char*)(ws + WS_WBG), (const char*)(ws + WS_SQ), (const char*)(ws + WS_SY), (const char*)(ws + WS_SQC), (const char*)(ws + WS_W3), G, bx};
        pg8::EpiMerge E{(u32x4*)(ws + WS_GSCR) + (size_t)bx * 16 * 512, IN(27), (bf16_t*)(ws + WS_MERGED)};
        pg8::gemm_phase(lds, 1024, S, E);
    }
    GRID_SYNC();
    {
        {
            FRESH();
            constexpr int NIT = 3 * 1408;
            for (int it = gw; it < NIT; it += NGW) {
                int r = it;
                CONV(IN(31), 1024, DFF, (bf16_t*)(ws + WS_WGU), 1, 0);
                CONV(IN(32), 1024, DFF, (bf16_t*)(ws + WS_WGU), 1, 128);
                if (r >= 0) transpose_item(IN(33), DFF, 1024, (bf16_t*)(ws + WS_WD), 0, 0, scr, r, lane);
            }
            __syncthreads();
        }
        unsigned* ctl = (unsigned*)(ws + WS_CTL);
        pg8::SchedPlain S{(const char*)(ws + WS_MERGED), (const char*)(ws + WS_WMIX), 1024, 64, 4, G, bx};
        pg8::RmsExchange st1{(unsigned*)(ws + WS_XSLOT), ctl + CW_CNT + 2 * 4096, ctl + 2}, st2{(unsigned*)(ws + WS_XSLOT) + 65536, ctl + CW_CNT + 3 * 4096, ctl + 2};
        pg8::EpiRmsRes<true> E{out, out, Hb, IN(29), IN(30), 1.0f, st1, st2};
        pg8::gemm_phase(lds, 1024, S, E);
    }
    GRID_SYNC();
    {
        pg8::SchedTwo S{(const char*)Hb, (const char*)(ws + WS_WGU), (const char*)Hb, (const char*)(ws + WS_WGU), 1024, 64, 22, 0, 0, G, bx};
        pg8::EpiSwigluKv E{(bf16_t*)(ws + WS_ACT2), (bf16_t*)(ws + WS_ACT2), 2048};
        pg8::gemm_phase(lds, 1024, S, E);
    }
    GRID_SYNC();
    {
        unsigned* ctl = (unsigned*)(ws + WS_CTL);
        pg8::SchedPlain S{(const char*)(ws + WS_ACT2), (const char*)(ws + WS_WD), DFF, 64, 4, G, bx};
        pg8::RmsExchange st1{(unsigned*)(ws + WS_XSLOT), ctl + CW_CNT + 4 * 4096, ctl + 2};
        pg8::EpiRmsRes<false> E{out, out, nullptr, IN(34), nullptr, 0.5f, st1, st1};
        pg8::gemm_phase(lds, DFF, S, E);
    }
}

extern "C" void kernel_launch(void* const* d_in, const int* in_sizes, int n_in, void* d_out, int out_size, void* d_ws, size_t ws_size, hipStream_t stream) {
    static int grid = 0;
    if (grid == 0) {
        if (n_in != 35 || ws_size < WS_END) { fprintf(stderr, "kernel_launch: unexpected inputs (n_in %d, ws %zu)\n", n_in, ws_size); grid = -1; return; }
        int dev = 0, cus = 0, per_cu = 0;
        hipGetDevice(&dev);
        hipDeviceGetAttribute(&cus, hipDeviceAttributeMultiprocessorCount, dev);
        hipFuncSetAttribute((const void*)fwd_megakernel, hipFuncAttributeMaxDynamicSharedMemorySize, LDS_BYTES);
        hipOccupancyMaxActiveBlocksPerMultiprocessor(&per_cu, (const void*)fwd_megakernel, NWAVES * 64, LDS_BYTES);
        if (per_cu < 1) per_cu = 1;
        grid = cus > 256 ? 256 : cus;
        (void)hipGetLastError();
    }
    if (grid < 0) return;
    Args a{};
    for (int i = 0; i < 35; ++i) a.in[i] = (const float*)d_in[i];
    a.out = (float*)d_out; a.ws = (unsigned char*)d_ws;
    void* kargs[] = {&a};
    hipError_t e = hipLaunchCooperativeKernel((const void*)fwd_megakernel, dim3(grid), dim3(NWAVES * 64), kargs, LDS_BYTES, stream);
    if (e != hipSuccess) fprintf(stderr, "cooperative launch failed: %s (grid %d)\n", hipGetErrorString(e), grid);
}
```

```cpp
#include <hip/hip_runtime.h>
#include <hip/hip_cooperative_groups.h>
#include <cstdio>
#include <cstdint>
namespace cg = cooperative_groups;

#define LAS __attribute__((address_space(3)))
typedef unsigned short bf16_t;
typedef short bf16x8 __attribute__((ext_vector_type(8)));
typedef short s16x4 __attribute__((ext_vector_type(4)));
typedef float f32x4 __attribute__((ext_vector_type(4)));
typedef float f32x2 __attribute__((ext_vector_type(2)));
typedef unsigned u32x4 __attribute__((ext_vector_type(4)));
typedef unsigned u32x2 __attribute__((ext_vector_type(2)));

constexpr int T = 16384, D = 1024, SEQ = 2048, NB = 8, DFF = 2816, NMEM = 256;
constexpr float EPS = 1e-6f;
constexpr float LOG2E = 1.4426950408889634f;

constexpr size_t MiB = 1u << 20;
constexpr size_t WS_CTL = 0;
constexpr size_t WS_WLRU = 1 * MiB;
constexpr size_t WS_KVM = 2 * MiB;
constexpr size_t WS_MEMN = 10 * MiB;
constexpr size_t WS_WKV = 14 * MiB;
constexpr size_t WS_WIN = 18 * MiB;
constexpr size_t WS_W3 = 18 * MiB, WS_WBG = 24 * MiB;
constexpr size_t WS_WMIX = 30 * MiB;
constexpr size_t WS_H = 32 * MiB;
constexpr size_t WS_BIG = 64 * MiB;
constexpr size_t WS_WGU = 64 * MiB;
constexpr size_t WS_WD = 75 * MiB;
constexpr size_t WS_ACT1 = 84 * MiB;
constexpr size_t SLOT = 32 * MiB;
constexpr size_t WS_SQ = 64 * MiB, WS_SK = 96 * MiB, WS_SV = 128 * MiB, WS_SX = 160 * MiB, WS_SY = 192 * MiB, WS_SQC = 224 * MiB;
constexpr size_t WS_GSCR = 96 * MiB;
constexpr size_t WS_MERGED = 160 * MiB;
constexpr size_t WS_ACT2 = 160 * MiB;
constexpr size_t WS_XSLOT = 1 * MiB + 512 * 1024;
constexpr int CW_CNT = 8192;
constexpr size_t WS_END = 256 * MiB;

typedef __bf16 bf16x2_t __attribute__((ext_vector_type(2)));
__device__ __forceinline__ unsigned cvt_pk_bf16(float lo, float hi) { const f32x2 v = {lo, hi}; const bf16x2_t b = __builtin_convertvector(v, bf16x2_t); return __builtin_bit_cast(unsigned, b); }
__device__ __forceinline__ float bf_lo(unsigned u) { return __uint_as_float(u << 16); }
__device__ __forceinline__ float bf_hi(unsigned u) { return __uint_as_float(u & 0xffff0000u); }
__device__ __forceinline__ float bf2f(bf16_t v) { return __uint_as_float(((unsigned)v) << 16); }
__device__ __forceinline__ bf16_t f2bf(float f) { return (bf16_t)(cvt_pk_bf16(f, 0.f) & 0xffffu); }
__device__ __forceinline__ float fast_rcp(float x) { return __builtin_amdgcn_rcpf(x); }
__device__ __forceinline__ float fast_exp2(float x) { return __builtin_amdgcn_exp2f(x); }
__device__ __forceinline__ float sigmoidf_(float x) { return fast_rcp(1.f + fast_exp2(-x * LOG2E)); }
__device__ __forceinline__ float xmax16(float v) { auto r = __builtin_amdgcn_permlane16_swap(__float_as_uint(v), __float_as_uint(v), false, false); return fmaxf(__uint_as_float(r[0]), __uint_as_float(r[1])); }
__device__ __forceinline__ float xmax32(float v) { auto r = __builtin_amdgcn_permlane32_swap(__float_as_uint(v), __float_as_uint(v), false, false); return fmaxf(__uint_as_float(r[0]), __uint_as_float(r[1])); }
__device__ __forceinline__ float xsum16(float v) { auto r = __builtin_amdgcn_permlane16_swap(__float_as_uint(v), __float_as_uint(v), false, false); return __uint_as_float(r[0]) + __uint_as_float(r[1]); }
__device__ __forceinline__ float xsum32(float v) { auto r = __builtin_amdgcn_permlane32_swap(__float_as_uint(v), __float_as_uint(v), false, false); return __uint_as_float(r[0]) + __uint_as_float(r[1]); }
__device__ __forceinline__ float wave_sum(float v) {
#pragma unroll
    for (int o = 1; o < 64; o <<= 1) v += __shfl_xor(v, o);
    return v;
}

namespace pg8 {
constexpr int BM = 256, BK = 64, HALF = 128, HTB = HALF * BK * 2, STAGE_BYTES = 8 * HTB, NXCD = 8, WGM = 8;
__host__ __device__ __forceinline__ int lds_byte(int r, int c) { const int st = (r >> 4) * 2 + (c >> 5), rr = r & 15, cc = c & 31, ob = rr * 64 + cc * 2; return st * 1024 + (ob ^ (((ob >> 9) & 1) << 5)); }
__host__ __device__ __forceinline__ void stage_rc(int b, int& R, int& C) { const int st = b / 1024, sb = b % 1024, swz = sb ^ (((sb >> 9) & 1) << 5); R = (st >> 1) * 16 + swz / 64; C = (st & 1) * 32 + (swz % 64) / 2; }
__host__ __device__ __forceinline__ int perm32(int rho) { const int n = rho >> 4, i = rho & 15; return 8 * (i >> 2) + 4 * n + (i & 3); }

struct Unit { int pm, pn, kind; };

__device__ __forceinline__ void tile_of(int L, int nM, int nN, int& pm, int& pn) {
    const int nwg = nM * nN;
    int wgid = L; { const int q = nwg / NXCD, r = nwg % NXCD, xcd = wgid % NXCD, off = wgid / NXCD; wgid = (xcd < r ? xcd * (q + 1) : r * (q + 1) + (xcd - r) * q) + off; }
    const int nig = WGM * nN, gid = wgid / nig, fm = gid * WGM, gsz = (nM - fm) < WGM ? (nM - fm) : WGM;
    pm = fm + ((wgid % nig) % gsz); pn = (wgid % nig) / gsz;
}

template <class Epi, class Sched>
__device__ __forceinline__ void gemm_phase(LAS unsigned char* lds, const int K, const Sched& S, const Epi& E) {
    int tid = threadIdx.x; asm volatile("" : "+v"(tid));
    const int wid = __builtin_amdgcn_readfirstlane(tid >> 6), lane = tid & 63, wr = wid >> 2, wc = wid & 3, fr = lane & 15, fq = lane >> 4;
    const int nt = K / BK;
    unsigned voffA[2], voffB[2];
#pragma unroll
    for (int i = 0; i < 2; ++i) { int R, C; stage_rc(tid * 16 + i * 8192, R, C); const int Rb = Epi::PERM ? ((R & ~31) + perm32(R & 31)) : R;
        voffA[i] = (unsigned)(R * K + C) * 2u; voffB[i] = (unsigned)(Rb * K + C) * 2u; }
    const size_t kstep = (size_t)(BK * 2);
    const size_t hstep = (size_t)HALF * K * 2;
    const unsigned ldsw = (unsigned)wid * 1024u;
    const int aoff = lds_byte(wr * 64 + fr, fq * 8), boff = lds_byte(wc * 32 + fr, fq * 8);
#define PG8_SA(b, h) (((b) * 2 + (h)) * HTB)
#define PG8_SB(b, h) ((4 + (b) * 2 + (h)) * HTB)
#define PG8_STAGE(bufoff, gbase, voff) do { _Pragma("unroll") for (int _i = 0; _i < 2; ++_i) \
        __builtin_amdgcn_global_load_lds((const unsigned*)((const char*)(gbase) + (voff)[_i]), (LAS unsigned*)(lds + (bufoff) + ldsw + _i * 8192), 16, 0, 0); } while (0)
#define PG8_LDA(dst, b, h) do { _Pragma("unroll") for (int m = 0; m < 4; ++m) _Pragma("unroll") for (int k = 0; k < 2; ++k) dst[m][k] = *(const LAS bf16x8*)(lds + PG8_SA(b, h) + aoff + m * 2048 + k * 1024); } while (0)
#define PG8_LDB(dst, b, h) do { _Pragma("unroll") for (int n = 0; n < 2; ++n) _Pragma("unroll") for (int k = 0; k < 2; ++k) dst[n][k] = *(const LAS bf16x8*)(lds + PG8_SB(b, h) + boff + n * 2048 + k * 1024); } while (0)
#define PG8_MMA(ai, bj, At, Bt) do { __builtin_amdgcn_s_setprio(1); _Pragma("unroll") for (int m = 0; m < 4; ++m) _Pragma("unroll") for (int n = 0; n < 2; ++n) _Pragma("unroll") for (int k = 0; k < 2; ++k) \
        acc[ai][bj][m][n] = __builtin_amdgcn_mfma_f32_16x16x32_bf16(Bt[n][k], At[m][k], acc[ai][bj][m][n], 0, 0, 0); __builtin_amdgcn_s_setprio(0); } while (0)
#define PG8_WAIT_V(n) asm volatile("s_waitcnt vmcnt(" #n ")" ::: "memory")
#define PG8_WAIT_L(n) asm volatile("s_waitcnt lgkmcnt(" #n ")" ::: "memory")
#define PG8_BAR __builtin_amdgcn_s_barrier()
#define PG8_SCHED __builtin_amdgcn_sched_barrier(0)
    Unit cur, nxt; int ui = 0;
    if (!S.next(0, cur)) return;
    f32x4 acc[2][2][4][2];
#pragma unroll
    for (int a = 0; a < 2; ++a)
#pragma unroll
        for (int b = 0; b < 2; ++b)
#pragma unroll
            for (int m = 0; m < 4; ++m)
#pragma unroll
                for (int n = 0; n < 2; ++n) acc[a][b][m][n] = (f32x4){0.f, 0.f, 0.f, 0.f};
    bf16x8 At[4][2], B0[2][2], B1[2][2];
    const char* cA = S.a_ptr(cur); const char* cB = S.b_ptr(cur);
    PG8_STAGE(PG8_SB(0, 0), cB, voffB); PG8_STAGE(PG8_SB(0, 1), cB + hstep, voffB); PG8_STAGE(PG8_SA(0, 0), cA, voffA); PG8_STAGE(PG8_SA(0, 1), cA + hstep, voffA);
    if (wr == 1) PG8_BAR;
    PG8_WAIT_V(2); PG8_BAR;
    PG8_STAGE(PG8_SB(1, 0), cB + kstep, voffB); PG8_STAGE(PG8_SA(1, 0), cA + kstep, voffA); PG8_STAGE(PG8_SB(1, 1), cB + hstep + kstep, voffB);
    PG8_WAIT_V(6); PG8_BAR;
    for (;;) {
        const bool has_next = S.next(ui + 1, nxt);
        const char* nA = has_next ? S.a_ptr(nxt) : cA; const char* nB = has_next ? S.b_ptr(nxt) : cB;
        for (int t = 0; t < nt; t += 2) {
            const bool last = (t == nt - 2);
            const char* a1 = cA + (size_t)(t + 1) * kstep;
            const char* a2 = last ? nA : cA + (size_t)(t + 2) * kstep; const char* b2 = last ? nB : cB + (size_t)(t + 2) * kstep;
            const char* a3 = a2 + kstep; const char* b3 = b2 + kstep;
            PG8_LDB(B0, 0, 0); PG8_LDB(B1, 0, 1); PG8_SCHED; PG8_LDA(At, 0, 0); PG8_STAGE(PG8_SA(1, 1), a1 + hstep, voffA);
            PG8_WAIT_V(8); PG8_WAIT_L(0); PG8_BAR; PG8_MMA(0, 0, At, B0); PG8_MMA(0, 1, At, B1); PG8_BAR; PG8_SCHED;
            PG8_LDA(At, 0, 1); PG8_STAGE(PG8_SB(0, 0), b2, voffB); PG8_STAGE(PG8_SB(0, 1), b2 + hstep, voffB); PG8_STAGE(PG8_SA(0, 0), a2, voffA);
            PG8_WAIT_V(8); PG8_WAIT_L(0); PG8_BAR; PG8_MMA(1, 0, At, B0); PG8_MMA(1, 1, At, B1); PG8_BAR; PG8_SCHED;
            PG8_LDB(B0, 1, 0); PG8_LDB(B1, 1, 1); PG8_SCHED; PG8_LDA(At, 1, 0); PG8_STAGE(PG8_SA(0, 1), a2 + hstep, voffA);
            PG8_WAIT_V(8); PG8_WAIT_L(0); PG8_BAR; PG8_MMA(0, 0, At, B0); PG8_MMA(0, 1, At, B1); PG8_BAR; PG8_SCHED;
            PG8_LDA(At, 1, 1); PG8_STAGE(PG8_SB(1, 0), b3, voffB); PG8_STAGE(PG8_SB(1, 1), b3 + hstep, voffB); PG8_STAGE(PG8_SA(1, 0), a3, voffA);
            PG8_WAIT_V(8); PG8_WAIT_L(0); PG8_BAR; PG8_MMA(1, 0, At, B0); PG8_MMA(1, 1, At, B1); PG8_BAR; PG8_SCHED;
        }
        if (wr == 0) PG8_BAR;
        if constexpr (!Epi::AFTER_DRAIN) E(acc, cur, wr, wc, fr, fq);
        if (!has_next) break;
#pragma unroll
        for (int a = 0; a < 2; ++a)
#pragma unroll
            for (int b = 0; b < 2; ++b)
#pragma unroll
                for (int m = 0; m < 4; ++m)
#pragma unroll
                    for (int n = 0; n < 2; ++n) acc[a][b][m][n] = (f32x4){0.f, 0.f, 0.f, 0.f};
        cur = nxt; cA = nA; cB = nB; ++ui;
        if (wr == 1) PG8_BAR;
    }
    PG8_WAIT_V(0);
    PG8_BAR;
    if constexpr (Epi::AFTER_DRAIN) E.fused(acc, cur, wr, wc, fr, fq, lds, wid, lane);
#undef PG8_SA
#undef PG8_SB
#undef PG8_STAGE
#undef PG8_LDA
#undef PG8_LDB
#undef PG8_MMA
#undef PG8_WAIT_V
#undef PG8_WAIT_L
#undef PG8_BAR
#undef PG8_SCHED
}

struct SchedPlain {
    const char* A; const char* Bt; int K, nM, nN, G, c;
    __device__ __forceinline__ bool next(int i, Unit& u) const { const long L = (long)i * G + c; if (L >= (long)nM * nN) return false; tile_of((int)L, nM, nN, u.pm, u.pn); u.kind = 0; return true; }
    __device__ __forceinline__ const char* a_ptr(const Unit& u) const { return A + (size_t)u.pm * BM * K * 2; }
    __device__ __forceinline__ const char* b_ptr(const Unit& u) const { return Bt + (size_t)u.pn * BM * K * 2; }
};
struct SchedTwo {
    const char* A0; const char* B0; const char* A1; const char* B1; int K, nM0, nN0, nM1, nN1, G, c;
    __device__ __forceinline__ bool next(int i, Unit& u) const {
        const long L = (long)i * G + c; const int n0 = nM0 * nN0;
        if (L < n0) { tile_of((int)L, nM0, nN0, u.pm, u.pn); u.kind = 0; return true; }
        const int j = (int)(L - n0); if (j >= nM1 * nN1) return false;
        u.pm = j / nN1; u.pn = j % nN1; u.kind = 1; return true; }
    __device__ __forceinline__ const char* a_ptr(const Unit& u) const { return (u.kind ? A1 : A0) + (size_t)u.pm * BM * K * 2; }
    __device__ __forceinline__ const char* b_ptr(const Unit& u) const { return (u.kind ? B1 : B0) + (size_t)u.pn * BM * K * 2; }
};
struct SchedMerge {
    const char* H; const char* Wbg; const char* O0; const char* O1; const char* O2; const char* W3; int G, c;
    __device__ __forceinline__ bool next(int i, Unit& u) const { const int t = (i / 6) * G + c; if (t >= 256) return false; tile_of(t, 64, 4, u.pm, u.pn); u.kind = i % 6; return true; }
    __device__ __forceinline__ const char* a_ptr(const Unit& u) const { const int b = u.kind >> 1; const char* base = (u.kind & 1) ? (b == 0 ? O0 : (b == 1 ? O1 : O2)) : H; return base + (size_t)u.pm * BM * 1024 * 2; }
    __device__ __forceinline__ const char* b_ptr(const Unit& u) const { const int b = u.kind >> 1; const char* base = (u.kind & 1) ? W3 : Wbg; return base + ((size_t)b * 1024 + (size_t)u.pn * BM) * 1024 * 2; }
};

struct EpiSwigluKv {
    static constexpr bool AFTER_DRAIN = false;
    static constexpr bool PERM = true;
    bf16_t* act; bf16_t* O1; int ldc1;
    __device__ __forceinline__ void operator()(const f32x4 (&acc)[2][2][4][2], const Unit& u, int wr, int wc, int fr, int fq) const {
        const int row0 = u.pm * BM + wr * 64 + fr;
        if (u.kind == 0) {
            const int col0 = u.pn * 128 + wc * 32 + 8 * fq;
#pragma unroll
            for (int ai = 0; ai < 2; ++ai)
#pragma unroll
                for (int m = 0; m < 4; ++m) {
                    bf16_t* rowp = act + (size_t)(row0 + ai * HALF + m * 16) * DFF + col0;
                    float o[8];
#pragma unroll
                    for (int n = 0; n < 2; ++n)
#pragma unroll
                        for (int j = 0; j < 4; ++j) { const float g = acc[ai][0][m][n][j], up = acc[ai][1][m][n][j]; o[n * 4 + j] = g * sigmoidf_(g) * up; }
                    u32x4 w; w.x = cvt_pk_bf16(o[0], o[1]); w.y = cvt_pk_bf16(o[2], o[3]); w.z = cvt_pk_bf16(o[4], o[5]); w.w = cvt_pk_bf16(o[6], o[7]);
                    *(u32x4*)rowp = w;
                }
        } else {
            const int col0 = u.pn * BM + wc * 32 + 8 * fq;
#pragma unroll
            for (int ai = 0; ai < 2; ++ai)
#pragma unroll
                for (int m = 0; m < 4; ++m) {
                    bf16_t* rowp = O1 + (size_t)(row0 + ai * HALF + m * 16) * ldc1 + col0;
#pragma unroll
                    for (int bj = 0; bj < 2; ++bj) { const f32x4 v0 = acc[ai][bj][m][0], v1 = acc[ai][bj][m][1];
                        u32x4 w; w.x = cvt_pk_bf16(v0[0], v0[1]); w.y = cvt_pk_bf16(v0[2], v0[3]); w.z = cvt_pk_bf16(v1[0], v1[1]); w.w = cvt_pk_bf16(v1[2], v1[3]);
                        *(u32x4*)(rowp + bj * HALF) = w; }
                }
        }
    }
};
struct EpiSplitBf16 {
    static constexpr bool AFTER_DRAIN = false;
    static constexpr bool PERM = true;
    bf16_t* O; size_t split_stride;
    __device__ __forceinline__ void operator()(const f32x4 (&acc)[2][2][4][2], const Unit& u, int wr, int wc, int fr, int fq) const {
        const int row0 = u.pm * BM + wr * 64 + fr; int colt = u.pn * BM; const int t = colt >> 10; colt &= 1023;
        bf16_t* base = O + (size_t)t * split_stride; const int col0 = colt + wc * 32 + 8 * fq;
#pragma unroll
        for (int ai = 0; ai < 2; ++ai)
#pragma unroll
            for (int m = 0; m < 4; ++m) {
                bf16_t* rowp = base + (size_t)(row0 + ai * HALF + m * 16) * 1024 + col0;
#pragma unroll
                for (int bj = 0; bj < 2; ++bj) { const f32x4 v0 = acc[ai][bj][m][0], v1 = acc[ai][bj][m][1];
                    u32x4 w; w.x = cvt_pk_bf16(v0[0], v0[1]); w.y = cvt_pk_bf16(v0[2], v0[3]); w.z = cvt_pk_bf16(v1[0], v1[1]); w.w = cvt_pk_bf16(v1[2], v1[3]);
                    *(u32x4*)(rowp + bj * HALF) = w; }
            }
    }
};
struct EpiMerge {
    static constexpr bool AFTER_DRAIN = false;
    static constexpr bool PERM = true;
    u32x4* gscr; const float* bias; bf16_t* merged;
    __device__ __forceinline__ void operator()(const f32x4 (&acc)[2][2][4][2], const Unit& u, int wr, int wc, int fr, int fq) const {
        const int b = u.kind >> 1; int tid = threadIdx.x; asm volatile("" : "+v"(tid));
        const int row0 = u.pm * BM + wr * 64 + fr, col0 = u.pn * BM + wc * 32 + 8 * fq;
        if ((u.kind & 1) == 0) {
#pragma unroll
            for (int bj = 0; bj < 2; ++bj) {
                const f32x4 b0 = *(const f32x4*)(bias + b * 1024 + col0 + bj * HALF), b1 = *(const f32x4*)(bias + b * 1024 + col0 + bj * HALF + 4);
#pragma unroll
                for (int ai = 0; ai < 2; ++ai)
#pragma unroll
                    for (int m = 0; m < 4; ++m) { const f32x4 v0 = acc[ai][bj][m][0] + b0, v1 = acc[ai][bj][m][1] + b1;
                        u32x4 w; w.x = cvt_pk_bf16(sigmoidf_(v0[0]), sigmoidf_(v0[1])); w.y = cvt_pk_bf16(sigmoidf_(v0[2]), sigmoidf_(v0[3]));
                        w.z = cvt_pk_bf16(sigmoidf_(v1[0]), sigmoidf_(v1[1])); w.w = cvt_pk_bf16(sigmoidf_(v1[2]), sigmoidf_(v1[3]));
                        gscr[((ai * 4 + m) * 2 + bj) * 512 + tid] = w; }
            }
        } else {
#pragma unroll
            for (int ai = 0; ai < 2; ++ai)
#pragma unroll
                for (int bj = 0; bj < 2; ++bj) {
                    u32x4 gw[4], old[4];
#pragma unroll
                    for (int m = 0; m < 4; ++m) gw[m] = gscr[((ai * 4 + m) * 2 + bj) * 512 + tid];
                    if (b != 0) {
#pragma unroll
                        for (int m = 0; m < 4; ++m) old[m] = *(const u32x4*)(merged + (size_t)(row0 + ai * HALF + m * 16) * 1024 + col0 + bj * HALF);
                    }
#pragma unroll
                    for (int m = 0; m < 4; ++m) {
                        const f32x4 v0 = acc[ai][bj][m][0], v1 = acc[ai][bj][m][1];
                        float o[8];
                        o[0] = bf_lo(gw[m].x) * v0[0]; o[1] = bf_hi(gw[m].x) * v0[1]; o[2] = bf_lo(gw[m].y) * v0[2]; o[3] = bf_hi(gw[m].y) * v0[3];
                        o[4] = bf_lo(gw[m].z) * v1[0]; o[5] = bf_hi(gw[m].z) * v1[1]; o[6] = bf_lo(gw[m].w) * v1[2]; o[7] = bf_hi(gw[m].w) * v1[3];
                        if (b != 0) {
                            o[0] += bf_lo(old[m].x); o[1] += bf_hi(old[m].x); o[2] += bf_lo(old[m].y); o[3] += bf_hi(old[m].y);
                            o[4] += bf_lo(old[m].z); o[5] += bf_hi(old[m].z); o[6] += bf_lo(old[m].w); o[7] += bf_hi(old[m].w); }
                        u32x4 w; w.x = cvt_pk_bf16(o[0], o[1]); w.y = cvt_pk_bf16(o[2], o[3]); w.z = cvt_pk_bf16(o[4], o[5]); w.w = cvt_pk_bf16(o[6], o[7]);
                        *(u32x4*)(merged + (size_t)(row0 + ai * HALF + m * 16) * 1024 + col0 + bj * HALF) = w;
                    }
                    asm volatile("" ::: "memory");
                }
        }
    }
};

struct RmsExchange {
    unsigned* xbuf;
    unsigned* cnt;
    unsigned* tmo;
    __device__ __forceinline__ void run(const f32x4 (&v)[2][2][4][2], const Unit& u, int wr, int wc, int fr, int fq, LAS unsigned char* lds, int wid, int lane) const {
        LAS float* P = (LAS float*)lds; LAS float* S = (LAS float*)(lds + 8192);
#pragma unroll
        for (int ai = 0; ai < 2; ++ai)
#pragma unroll
            for (int m = 0; m < 4; ++m) {
                float q = 0.f;
#pragma unroll
                for (int bj = 0; bj < 2; ++bj)
#pragma unroll
                    for (int n = 0; n < 2; ++n) { const f32x4 x = v[ai][bj][m][n]; q += (x[0] * x[0] + x[1] * x[1]) + (x[2] * x[2] + x[3] * x[3]); }
                q = xsum32(xsum16(q));
                if (fq == 0) P[(ai * HALF + wr * 64 + m * 16 + fr) * 4 + wc] = q;
            }
        asm volatile("s_waitcnt lgkmcnt(0)" ::: "memory"); __builtin_amdgcn_s_barrier(); asm volatile("" ::: "memory");
        const int row = wid * 32 + (lane & 31);
        if (lane < 32) {
            const float t = (P[row * 4 + 0] + P[row * 4 + 1]) + (P[row * 4 + 2] + P[row * 4 + 3]);
            __hip_atomic_store(xbuf + ((size_t)(u.pm * BM + row) * 4 + u.pn), __float_as_uint(t), __ATOMIC_RELAXED, __HIP_MEMORY_SCOPE_AGENT);
        }
        asm volatile("s_waitcnt vmcnt(0)" ::: "memory");
        if (lane == 0) __hip_atomic_fetch_add(cnt + 64 * u.pm, 1u, __ATOMIC_RELAXED, __HIP_MEMORY_SCOPE_AGENT);
        if (wid == 0) {
            unsigned sp = 0u;
            for (;;) {
                if ((unsigned)__builtin_amdgcn_readfirstlane(__hip_atomic_load(cnt + 64 * u.pm, __ATOMIC_RELAXED, __HIP_MEMORY_SCOPE_AGENT)) >= 32u) break;
                if (++sp > (1u << 20)) { if (lane == 0) __hip_atomic_store(tmo, 1u, __ATOMIC_RELAXED, __HIP_MEMORY_SCOPE_AGENT); break; }
                __builtin_amdgcn_s_sleep(2);
            }
            __builtin_amdgcn_fence(__ATOMIC_ACQUIRE, "agent");
        }
        asm volatile("s_waitcnt vmcnt(0) lgkmcnt(0)" ::: "memory"); __builtin_amdgcn_s_barrier(); asm volatile("" ::: "memory");
        if (lane < 32) {
            const unsigned* slot = xbuf + (size_t)(u.pm * BM + row) * 4; float t = 0.f;
#pragma unroll
            for (int p = 0; p < 4; ++p) t += __uint_as_float(__hip_atomic_load(slot + p, __ATOMIC_RELAXED, __HIP_MEMORY_SCOPE_AGENT));
            S[row] = 1.0f / sqrtf(t * (1.f / 1024.f) + 1e-6f);
        }
        asm volatile("s_waitcnt lgkmcnt(0)" ::: "memory"); __builtin_amdgcn_s_barrier(); asm volatile("" ::: "memory");
    }
};
template <bool HAS_H> struct EpiRmsRes {
    static constexpr bool PERM = false, AFTER_DRAIN = true;
    const float* base; float* out; bf16_t* hb; const float* gpost; const float* gpre; float wgt; RmsExchange st1, st2;
    __device__ __forceinline__ void operator()(const f32x4 (&)[2][2][4][2], const Unit&, int, int, int, int) const {}
    __device__ __forceinline__ void fused(f32x4 (&acc)[2][2][4][2], const Unit& u, int wr, int wc, int fr, int fq, LAS unsigned char* lds, int wid, int lane) const {
        const LAS float* S = (const LAS float*)(lds + 8192);
        const int col0 = u.pn * BM + wc * 32 + 4 * fq;
        f32x4 pre[4][2][2];
#pragma unroll
        for (int m = 0; m < 4; ++m) { const size_t off = (size_t)(u.pm * BM + wr * 64 + m * 16 + fr) * 1024 + col0;
#pragma unroll
            for (int bj = 0; bj < 2; ++bj)
#pragma unroll
                for (int n = 0; n < 2; ++n) pre[m][bj][n] = __builtin_nontemporal_load((const f32x4*)(base + off + bj * HALF + n * 16)); }
        st1.run(acc, u, wr, wc, fr, fq, lds, wid, lane);
        {
            f32x4 gp[2][2];
#pragma unroll
            for (int bj = 0; bj < 2; ++bj)
#pragma unroll
                for (int n = 0; n < 2; ++n) gp[bj][n] = *(const f32x4*)(gpost + col0 + bj * HALF + n * 16);
#pragma unroll
            for (int ai = 0; ai < 2; ++ai)
#pragma unroll
                for (int m = 0; m < 4; ++m) { const int r = ai * HALF + wr * 64 + m * 16 + fr; const float rs = S[r] * wgt;
#pragma unroll
                    for (int bj = 0; bj < 2; ++bj)
#pragma unroll
                        for (int n = 0; n < 2; ++n) acc[ai][bj][m][n] = pre[m][bj][n] + acc[ai][bj][m][n] * rs * gp[bj][n];
                    asm volatile("" : "+v"(acc[ai][0][m][0]), "+v"(acc[ai][0][m][1]), "+v"(acc[ai][1][m][0]), "+v"(acc[ai][1][m][1]));
                    if (ai == 0) {
                        const size_t off2 = (size_t)(u.pm * BM + HALF + wr * 64 + m * 16 + fr) * 1024 + col0;
#pragma unroll
                        for (int bj = 0; bj < 2; ++bj)
#pragma unroll
                            for (int n = 0; n < 2; ++n) pre[m][bj][n] = __builtin_nontemporal_load((const f32x4*)(base + off2 + bj * HALF + n * 16));
                    }
                }
        }
        if (HAS_H) st2.run(acc, u, wr, wc, fr, fq, lds, wid, lane);
        f32x4 gq[2][2];
        if (HAS_H) {
#pragma unroll
            for (int bj = 0; bj < 2; ++bj)
#pragma unroll
                for (int n = 0; n < 2; ++n) gq[bj][n] = *(const f32x4*)(gpre + col0 + bj * HALF + n * 16);
        }
#pragma unroll
        for (int ai = 0; ai < 2; ++ai)
#pragma unroll
            for (int m = 0; m < 4; ++m) { const int r = ai * HALF + wr * 64 + m * 16 + fr; const float rs2 = HAS_H ? S[r] : 0.f; const size_t off = (size_t)(u.pm * BM + r) * 1024 + col0;
#pragma unroll
                for (int bj = 0; bj < 2; ++bj) {
#pragma unroll
                    for (int n = 0; n < 2; ++n) *(f32x4*)(out + off + bj * HALF + n * 16) = acc[ai][bj][m][n];
                    if (HAS_H) {
                        const f32x4 oa = acc[ai][bj][m][0] * rs2 * gq[bj][0], ob = acc[ai][bj][m][1] * rs2 * gq[bj][1];
                        const unsigned ax = cvt_pk_bf16(oa[0], oa[1]), ay = cvt_pk_bf16(oa[2], oa[3]), bx_ = cvt_pk_bf16(ob[0], ob[1]), by_ = cvt_pk_bf16(ob[2], ob[3]);
                        const auto sx = __builtin_amdgcn_permlane16_swap(ax, bx_, false, false), sy = __builtin_amdgcn_permlane16_swap(ay, by_, false, false);
                        u32x4 w; w.x = sx[0]; w.y = sy[0]; w.z = sx[1]; w.w = sy[1];
                        *(u32x4*)(hb + (size_t)(u.pm * BM + r) * 1024 + u.pn * BM + wc * 32 + bj * HALF + 16 * (fq & 1) + 8 * (fq >> 1)) = w; }
                }
                asm volatile("" ::: "memory"); }
    }
};
}

__device__ __forceinline__ void transpose_item(const float* W, int K, int N, bf16_t* WT, int mode, int row_off, LAS float* scr, int item, int lane) {
    const int nblk = N / 32, kb = item / nblk, nb = item % nblk, k0 = 64 * kb, n0 = 32 * nb;
    { f32x4 v[8];
#pragma unroll
        for (int i = 0; i < 8; ++i) v[i] = __builtin_nontemporal_load((const f32x4*)(W + (size_t)(k0 + 8 * i + (lane >> 3)) * N + n0 + 4 * (lane & 7)));
#pragma unroll
        for (int i = 0; i < 8; ++i) { LAS float* d = scr + (8 * i + (lane >> 3)) * 33 + 4 * (lane & 7); d[0] = v[i].x; d[1] = v[i].y; d[2] = v[i].z; d[3] = v[i].w; } }
    asm volatile("s_waitcnt lgkmcnt(0)" ::: "memory");
    const int c = lane & 7;
    const int drow0 = (mode == 0) ? (row_off + n0) : ((n0 >> 7) * 256 + row_off + (n0 & 127));
#pragma unroll
    for (int j = 0; j < 4; ++j) { const int n = (lane >> 3) + 8 * j; const LAS float* s = scr + (8 * c) * 33 + n;
        u32x4 o; o.x = cvt_pk_bf16(s[0 * 33], s[1 * 33]); o.y = cvt_pk_bf16(s[2 * 33], s[3 * 33]); o.z = cvt_pk_bf16(s[4 * 33], s[5 * 33]); o.w = cvt_pk_bf16(s[6 * 33], s[7 * 33]);
        *(u32x4*)(WT + (size_t)(drow0 + n) * K + k0 + 8 * c) = o; }
    asm volatile("s_waitcnt lgkmcnt(0)" ::: "memory");
}

__device__ __forceinline__ void rms_row_to_bf16(const float* xrow, const float* g, bf16_t* orow, int lane) {
    const f32x4* xr = (const f32x4*)xrow + lane; const f32x4* gr = (const f32x4*)g + lane;
    f32x4 v[4]; float s = 0.f;
#pragma unroll
    for (int j = 0; j < 4; ++j) { v[j] = __builtin_nontemporal_load(xr + 64 * j); s += (v[j].x * v[j].x + v[j].y * v[j].y) + (v[j].z * v[j].z + v[j].w * v[j].w); }
    const float rs = 1.0f / sqrtf(wave_sum(s) * (1.f / 1024.f) + EPS);
    u32x2* o8 = (u32x2*)orow + lane;
#pragma unroll
    for (int j = 0; j < 4; ++j) { const f32x4 gg = gr[64 * j]; u32x2 w; w.x = cvt_pk_bf16(v[j].x * rs * gg.x, v[j].y * rs * gg.y); w.y = cvt_pk_bf16(v[j].z * rs * gg.z, v[j].w * rs * gg.w); o8[64 * j] = w; }
}
__device__ __forceinline__ void rms_row2_to_bf16(const float* xrow0, const float* xrow1, const float* g, bf16_t* orow0, bf16_t* orow1, int lane) {
    const f32x4* xa = (const f32x4*)xrow0 + lane; const f32x4* xb = (const f32x4*)xrow1 + lane; const f32x4* gr = (const f32x4*)g + lane;
    f32x4 va[4], vb[4], gg[4]; float sa = 0.f, sb = 0.f;
#pragma unroll
    for (int j = 0; j < 4; ++j) { va[j] = __builtin_nontemporal_load(xa + 64 * j); vb[j] = __builtin_nontemporal_load(xb + 64 * j); gg[j] = gr[64 * j]; }
#pragma unroll
    for (int j = 0; j < 4; ++j) { sa += (va[j].x * va[j].x + va[j].y * va[j].y) + (va[j].z * va[j].z + va[j].w * va[j].w); sb += (vb[j].x * vb[j].x + vb[j].y * vb[j].y) + (vb[j].z * vb[j].z + vb[j].w * vb[j].w); }
    const float ra = 1.0f / sqrtf(wave_sum(sa) * (1.f / 1024.f) + EPS), rb = 1.0f / sqrtf(wave_sum(sb) * (1.f / 1024.f) + EPS);
    u32x2* oa = (u32x2*)orow0 + lane; u32x2* ob = (u32x2*)orow1 + lane;
#pragma unroll
    for (int j = 0; j < 4; ++j) { u32x2 w; w.x = cvt_pk_bf16(va[j].x * ra * gg[j].x, va[j].y * ra * gg[j].y); w.y = cvt_pk_bf16(va[j].z * ra * gg[j].z, va[j].w * ra * gg[j].w); oa[64 * j] = w;
        u32x2 v; v.x = cvt_pk_bf16(vb[j].x * rb * gg[j].x, vb[j].y * rb * gg[j].y); v.y = cvt_pk_bf16(vb[j].z * rb * gg[j].z, vb[j].w * rb * gg[j].w); ob[64 * j] = v; }
}
template <int NMAPS, int DK, int DV, bool CAUSAL, bool STORE = true, bool ALIBI = CAUSAL>
__device__ __forceinline__ void attn_unit(LAS unsigned char* lds, const bf16_t* Qg, const bf16_t* Kg, int kpitch, const bf16_t* Vg, int vpitch, bf16_t* Og, int qpitch,
                                          int q0, int ntiles, float c1, float slope2, float lam, const float* head_g) {
    constexpr int KW = NMAPS * DK, KP = KW + 8, VP = DV + 16;
    constexpr int KCH = KW / 8, VCH = DV / 8, KLD = 64 * KCH / 512, VLD = 64 * VCH / 512;
    constexpr int NKS = DK / 32, NDT = DV / 16;
    constexpr int TILEB = 64 * KP * 2 + 64 * VP * 2;
    constexpr bool LATEW = (NMAPS == 1);
    static_assert(!LATEW || !CAUSAL, "late-write form has no skipped tiles");
    int tid = threadIdx.x; asm volatile("" : "+v"(tid));
    const int lane = tid & 63, wid = __builtin_amdgcn_readfirstlane(tid >> 6), qi = lane & 15, g = lane >> 4;
    bf16x8 qf[NMAPS][NKS];
    { const bf16_t* qrow = Qg + (size_t)(wid * 16 + qi) * qpitch;
#pragma unroll
      for (int m = 0; m < NMAPS; ++m)
#pragma unroll
          for (int ks = 0; ks < NKS; ++ks) qf[m][ks] = *(const bf16x8*)(qrow + m * DK + ks * 32 + g * 8); }
    f32x4 O[NMAPS][NDT]; float mrun[NMAPS], lrun[NMAPS];
#pragma unroll
    for (int m = 0; m < NMAPS; ++m) { mrun[m] = -INFINITY; lrun[m] = 0.f;
#pragma unroll
        for (int dt = 0; dt < NDT; ++dt) O[m][dt] = (f32x4){0.f, 0.f, 0.f, 0.f}; }
    u32x4 kreg[KLD], vreg[VLD];
#define ATT_LOADREGS(t) do { \
    _Pragma("unroll") for (int c_ = 0; c_ < KLD; ++c_) { const int idx_ = tid + c_ * 512, row_ = idx_ / KCH, ch_ = idx_ % KCH; kreg[c_] = *(const u32x4*)(Kg + (size_t)((t) * 64 + row_) * kpitch + ch_ * 8); } \
    _Pragma("unroll") for (int c_ = 0; c_ < VLD; ++c_) { const int idx_ = tid + c_ * 512, row_ = idx_ / VCH, ch_ = idx_ % VCH; vreg[c_] = *(const u32x4*)(Vg + (size_t)((t) * 64 + row_) * vpitch + ch_ * 8); } } while (0)
#define ATT_WRITELDS(Kw, Vw) do { \
    _Pragma("unroll") for (int c_ = 0; c_ < KLD; ++c_) { const int idx_ = tid + c_ * 512, row_ = idx_ / KCH, ch_ = idx_ % KCH; *(LAS u32x4*)(Kw + (row_ * KP + ch_ * 8) * 2) = kreg[c_]; } \
    _Pragma("unroll") for (int c_ = 0; c_ < VLD; ++c_) { const int idx_ = tid + c_ * 512, row_ = idx_ / VCH, ch_ = idx_ % VCH; *(LAS u32x4*)(Vw + (row_ * VP + ch_ * 8) * 2) = vreg[c_]; } } while (0)
#define ATT_TILE(i_) (CAUSAL ? (ntiles - 1 - (i_)) : (i_))
    __syncthreads();
    ATT_LOADREGS(ATT_TILE(0));
    ATT_WRITELDS(lds, lds + 64 * KP * 2);
    if (!LATEW && ntiles > 1) ATT_LOADREGS(ATT_TILE(1));
    __syncthreads();
    const int qpos = q0 + wid * 16 + qi;
    const int q4 = qi >> 2, p4 = qi & 3;
    f32x4 kbv[4];
#pragma unroll
    for (int tt = 0; tt < 4; ++tt)
#pragma unroll
        for (int r = 0; r < 4; ++r) kbv[tt][r] = ALIBI ? slope2 * (float)(16 * tt + 4 * g + r) : 0.f;
    for (int ti = 0; ti < ntiles; ++ti) {
        const int t = ATT_TILE(ti);
        LAS unsigned char* Kl = lds + (ti & 1) * TILEB; LAS unsigned char* Vl = Kl + 64 * KP * 2;
        if (!LATEW) {
            if (ti + 1 < ntiles) { LAS unsigned char* Kn = lds + ((ti + 1) & 1) * TILEB; ATT_WRITELDS(Kn, Kn + 64 * KP * 2); }
            if (ti + 2 < ntiles) ATT_LOADREGS(ATT_TILE(ti + 2));
        } else if (ti + 1 < ntiles) ATT_LOADREGS(ATT_TILE(ti + 1));
        const int k0 = 64 * t;
        const bool skip = CAUSAL && (k0 > q0 + wid * 16 + 15);
        if (!skip) {
            f32x4 s[NMAPS][4];
#pragma unroll
            for (int m = 0; m < NMAPS; ++m)
#pragma unroll
                for (int tt = 0; tt < 4; ++tt) { f32x4 a = (f32x4){0.f, 0.f, 0.f, 0.f};
#pragma unroll
                    for (int ks = 0; ks < NKS; ++ks) { const bf16x8 kf = *(const LAS bf16x8*)(Kl + ((16 * tt + qi) * KP + m * DK + ks * 32 + g * 8) * 2);
                        a = __builtin_amdgcn_mfma_f32_16x16x32_bf16(kf, qf[m][ks], a, 0, 0, 0); }
                    s[m][tt] = a; if (NKS > 2) __builtin_amdgcn_sched_barrier(0); }
            const bool needmask = CAUSAL && (k0 + 63 > q0 + wid * 16);
            const float tb = ALIBI ? slope2 * (float)k0 : 0.f;
            float mxv[NMAPS];
#pragma unroll
            for (int m = 0; m < NMAPS; ++m) {
#pragma unroll
                for (int tt = 0; tt < 4; ++tt) { s[m][tt] = ALIBI ? (s[m][tt] * c1 + kbv[tt]) : (s[m][tt] * c1);
                    if (needmask) {
#pragma unroll
                        for (int r = 0; r < 4; ++r) { const int kpos = k0 + 16 * tt + 4 * g + r; if (kpos > qpos) s[m][tt][r] = -INFINITY; } } }
                float mx = fmaxf(fmaxf(s[m][0][0], s[m][0][1]), s[m][0][2]);
                mx = fmaxf(fmaxf(mx, s[m][0][3]), s[m][1][0]); mx = fmaxf(fmaxf(mx, s[m][1][1]), s[m][1][2]); mx = fmaxf(fmaxf(mx, s[m][1][3]), s[m][2][0]);
                mx = fmaxf(fmaxf(mx, s[m][2][1]), s[m][2][2]); mx = fmaxf(fmaxf(mx, s[m][2][3]), s[m][3][0]); mx = fmaxf(fmaxf(mx, s[m][3][1]), s[m][3][2]); mx = fmaxf(mx, s[m][3][3]);
                mxv[m] = xmax32(xmax16(mx)) + tb;
            }
            bool dead = ALIBI;
#pragma unroll
            for (int m = 0; m < NMAPS; ++m) dead = dead && (mxv[m] - mrun[m] < -126.f);
            if (!(ALIBI && __all(dead))) {
#pragma unroll
            for (int m = 0; m < NMAPS; ++m) {
                const float mcand = fmaxf(mrun[m], mxv[m]);
                const float mnew = (mcand - mrun[m] > 8.f) ? mcand : mrun[m];
                const float alpha = fast_exp2(mrun[m] - mnew); mrun[m] = mnew;
                const float sub = mnew - tb;
                f32x4 ps4 = (f32x4){0.f, 0.f, 0.f, 0.f}; const f32x4 nsub4 = (f32x4){-sub, -sub, -sub, -sub};
#pragma unroll
                for (int tt = 0; tt < 4; ++tt) { const f32x4 d = s[m][tt] + nsub4; f32x4 p; p[0] = fast_exp2(d[0]); p[1] = fast_exp2(d[1]); p[2] = fast_exp2(d[2]); p[3] = fast_exp2(d[3]); s[m][tt] = p; ps4 = ps4 + p; }
                lrun[m] = lrun[m] * alpha + ((ps4[0] + ps4[1]) + (ps4[2] + ps4[3]));
                if (__any(alpha != 1.f)) {
#pragma unroll
                    for (int dt = 0; dt < NDT; ++dt) O[m][dt] = O[m][dt] * alpha;
                }
            }
            if (LATEW && ti + 1 < ntiles) { LAS unsigned char* Kn = lds + ((ti + 1) & 1) * TILEB; ATT_WRITELDS(Kn, Kn + 64 * KP * 2); }
#pragma unroll
            for (int kk = 0; kk < 2; ++kk) {
                bf16x8 pf[NMAPS];
#pragma unroll
                for (int m = 0; m < NMAPS; ++m) { u32x4 w; w.x = cvt_pk_bf16(s[m][2 * kk][0], s[m][2 * kk][1]); w.y = cvt_pk_bf16(s[m][2 * kk][2], s[m][2 * kk][3]);
                    w.z = cvt_pk_bf16(s[m][2 * kk + 1][0], s[m][2 * kk + 1][1]); w.w = cvt_pk_bf16(s[m][2 * kk + 1][2], s[m][2 * kk + 1][3]); pf[m] = __builtin_bit_cast(bf16x8, w); }
#pragma unroll
                for (int dt = 0; dt < NDT; ++dt) {
                    LAS unsigned char* vp = Vl + ((32 * kk + 4 * g + q4) * VP + 16 * dt + 4 * p4) * 2;
                    const s16x4 lo = __builtin_bit_cast(s16x4, __builtin_amdgcn_ds_read_tr16_b64_v4i16((LAS s16x4*)vp));
                    const s16x4 hi = __builtin_bit_cast(s16x4, __builtin_amdgcn_ds_read_tr16_b64_v4i16((LAS s16x4*)(vp + 16 * VP * 2)));
                    const bf16x8 vf = (bf16x8){lo[0], lo[1], lo[2], lo[3], hi[0], hi[1], hi[2], hi[3]};
#pragma unroll
                    for (int m = 0; m < NMAPS; ++m) O[m][dt] = __builtin_amdgcn_mfma_f32_16x16x32_bf16(vf, pf[m], O[m][dt], 0, 0, 0);
                    if (NDT > 8 && (dt & 3) == 3) __builtin_amdgcn_sched_barrier(0);
                }
            }
            }
        }
        __syncthreads();
    }
#undef ATT_TILE
#undef ATT_LOADREGS
#undef ATT_WRITELDS
    float inv[NMAPS];
#pragma unroll
    for (int m = 0; m < NMAPS; ++m) { const float l = xsum32(xsum16(lrun[m])); inv[m] = 1.0f / l; }
    bf16_t* orow = Og + (size_t)(wid * 16 + qi) * qpitch + 4 * g;
    if (NMAPS == 2) {
        float ss = 0.f;
#pragma unroll
        for (int dt = 0; dt < NDT; ++dt)
#pragma unroll
            for (int r = 0; r < 4; ++r) { const float o = O[0][dt][r] * inv[0] - lam * (O[NMAPS - 1][dt][r] * inv[NMAPS - 1]); O[0][dt][r] = o; ss += o * o; }
        ss = xsum32(xsum16(ss));
        const float rn = 0.8f / sqrtf(ss * (1.f / (float)DV) + EPS);
        bf16_t* orow16 = Og + (size_t)(wid * 16 + qi) * qpitch + 16 * (g & 1) + 8 * (g >> 1);
#pragma unroll
        for (int dp = 0; dp < NDT; dp += 2) { const f32x4 ga = *(const f32x4*)(head_g + 16 * dp + 4 * g), gb = *(const f32x4*)(head_g + 16 * dp + 16 + 4 * g);
            const unsigned ax = cvt_pk_bf16(O[0][dp][0] * rn * ga.x, O[0][dp][1] * rn * ga.y), ay = cvt_pk_bf16(O[0][dp][2] * rn * ga.z, O[0][dp][3] * rn * ga.w);
            const unsigned bx = cvt_pk_bf16(O[0][dp + 1][0] * rn * gb.x, O[0][dp + 1][1] * rn * gb.y), by = cvt_pk_bf16(O[0][dp + 1][2] * rn * gb.z, O[0][dp + 1][3] * rn * gb.w);
            const auto sx = __builtin_amdgcn_permlane16_swap(ax, bx, false, false), sy = __builtin_amdgcn_permlane16_swap(ay, by, false, false);
            u32x4 w; w.x = sx[0]; w.y = sy[0]; w.z = sx[1]; w.w = sy[1];
            if (STORE) *(u32x4*)(orow16 + 16 * dp) = w; else asm volatile("" :: "v"(w.x), "v"(w.y), "v"(w.z), "v"(w.w)); }
    } else {
        bf16_t* orow16 = Og + (size_t)(wid * 16 + qi) * qpitch + 16 * (g & 1) + 8 * (g >> 1);
#pragma unroll
        for (int dp = 0; dp < NDT; dp += 2) {
            const unsigned ax = cvt_pk_bf16(O[0][dp][0] * inv[0], O[0][dp][1] * inv[0]), ay = cvt_pk_bf16(O[0][dp][2] * inv[0], O[0][dp][3] * inv[0]);
            const unsigned bx = cvt_pk_bf16(O[0][dp + 1][0] * inv[0], O[0][dp + 1][1] * inv[0]), by = cvt_pk_bf16(O[0][dp + 1][2] * inv[0], O[0][dp + 1][3] * inv[0]);
            const auto sx = __builtin_amdgcn_permlane16_swap(ax, bx, false, false), sy = __builtin_amdgcn_permlane16_swap(ay, by, false, false);
            u32x4 w; w.x = sx[0]; w.y = sy[0]; w.z = sx[1]; w.w = sy[1];
            if (STORE) *(u32x4*)(orow16 + 16 * dp) = w; else asm volatile("" :: "v"(w.x), "v"(w.y), "v"(w.z), "v"(w.w)); }
    }
}

__device__ __forceinline__ float gelu_tanh(float y) {
    const float z = 0.7978845608028654f * (y + 0.044715f * y * y * y);
    const float e = fast_exp2(2.f * z * LOG2E);
    const float th = 1.f - 2.f * fast_rcp(e + 1.f);
    return 0.5f * y * (1.f + th);
}
template <bool STORE>
__device__ __forceinline__ void lru_unit(LAS unsigned char* lds, int b, int n, const bf16_t* X, bf16_t* Y, const bf16_t* WT,
                                         const float* conv_w, const float* conv_b, const float* b_a, const float* b_x, const float* lam) {
    constexpr int XP = 136;
    LAS bf16_t* Xl = (LAS bf16_t*)lds; LAS bf16_t* Yl = Xl + 128 * XP;
    int tid = threadIdx.x; asm volatile("" : "+v"(tid));
    const int lane = tid & 63, wid = __builtin_amdgcn_readfirstlane(tid >> 6), li = lane & 15, g = lane >> 4;
    const int ch = tid & 15, rbase = tid >> 4;
    const float* cwl = conv_w + 128 * n + 8 * ch; const float* cbl = conv_b + 128 * n + 8 * ch;
    const int cl = 16 * wid + li, cg_ = 128 * n + cl;
    const float ba = b_a[cg_], bx = b_x[cg_];
    const float sp8l2 = 8.f * log1pf(expf(-lam[cg_])) * LOG2E;
    bf16x8 wa[4], wx[4];
#pragma unroll
    for (int ks = 0; ks < 4; ++ks) { wa[ks] = *(const bf16x8*)(WT + ((size_t)(0 * 8 + n) * 128 + cl) * 128 + 32 * ks + 8 * g);
                                     wx[ks] = *(const bf16x8*)(WT + ((size_t)(1 * 8 + n) * 128 + cl) * 128 + 32 * ks + 8 * g); }
    float hc = 0.f;
    LAS bf16_t* Xr = Yl + 128 * XP;
    u32x4 xr[5], yr[4];
#define LRU_LOAD(c_) do { \
    _Pragma("unroll") for (int k_ = 0; k_ < 5; ++k_) { const int id_ = tid + 512 * k_, row_ = id_ >> 4, chx_ = id_ & 15; const int trel_ = 128 * (c_) - 3 + row_; \
        xr[k_] = (id_ < 131 * 16 && trel_ >= 0) ? *(const u32x4*)(X + ((size_t)b * SEQ + trel_) * 1024 + 128 * n + 8 * chx_) : (u32x4){0u, 0u, 0u, 0u}; } \
    _Pragma("unroll") for (int p_ = 0; p_ < 4; ++p_) yr[p_] = *(const u32x4*)(Y + ((size_t)b * SEQ + 128 * (c_) + rbase + 32 * p_) * 1024 + 128 * n + 8 * ch); } while (0)
    LRU_LOAD(0);
    for (int chunk = 0; chunk < 16; ++chunk) {
        const size_t tok0 = (size_t)b * SEQ + 128 * chunk;
        __syncthreads();
#pragma unroll
        for (int k = 0; k < 5; ++k) { const int id = tid + 512 * k, row = id >> 4, chx = id & 15; if (id < 131 * 16) *(LAS u32x4*)(Xr + row * XP + 8 * chx) = xr[k]; }
#pragma unroll
        for (int p = 0; p < 4; ++p) *(LAS u32x4*)(Yl + (rbase + 32 * p) * XP + 8 * ch) = yr[p];
        __syncthreads();
        if (chunk + 1 < 16) LRU_LOAD(chunk + 1);
        float cw[4][8], cb[8];
        { const float* cwp = cwl; const float* cbp = cbl; asm volatile("" : "+v"(cwp), "+v"(cbp));
          const f32x4 b0 = *(const f32x4*)cbp, b1 = *(const f32x4*)(cbp + 4); cb[0] = b0.x; cb[1] = b0.y; cb[2] = b0.z; cb[3] = b0.w; cb[4] = b1.x; cb[5] = b1.y; cb[6] = b1.z; cb[7] = b1.w;
#pragma unroll
          for (int j = 0; j < 4; ++j) { const f32x4 w0 = *(const f32x4*)(cwp + j * 1024), w1 = *(const f32x4*)(cwp + j * 1024 + 4);
              cw[j][0] = w0.x; cw[j][1] = w0.y; cw[j][2] = w0.z; cw[j][3] = w0.w; cw[j][4] = w1.x; cw[j][5] = w1.y; cw[j][6] = w1.z; cw[j][7] = w1.w; } }
#pragma unroll
        for (int p = 0; p < 4; ++p) {
            const int row = rbase + 32 * p;
            float a[8];
#pragma unroll
            for (int e = 0; e < 8; ++e) a[e] = cb[e];
#pragma unroll
            for (int j = 0; j < 4; ++j) { const u32x4 v = *(const LAS u32x4*)(Xr + (row + j) * XP + 8 * ch);
                a[0] += cw[j][0] * bf_lo(v.x); a[1] += cw[j][1] * bf_hi(v.x); a[2] += cw[j][2] * bf_lo(v.y); a[3] += cw[j][3] * bf_hi(v.y);
                a[4] += cw[j][4] * bf_lo(v.z); a[5] += cw[j][5] * bf_hi(v.z); a[6] += cw[j][6] * bf_lo(v.w); a[7] += cw[j][7] * bf_hi(v.w); }
            u32x4 w; w.x = cvt_pk_bf16(a[0], a[1]); w.y = cvt_pk_bf16(a[2], a[3]); w.z = cvt_pk_bf16(a[4], a[5]); w.w = cvt_pk_bf16(a[6], a[7]);
            *(LAS u32x4*)(Xl + row * XP + 8 * ch) = w;
        }
        __syncthreads();
        {
            float pa[8][4], pb[8][4];
#pragma unroll
            for (int tt = 0; tt < 8; ++tt) {
                f32x4 da = (f32x4){0.f, 0.f, 0.f, 0.f}, dx = (f32x4){0.f, 0.f, 0.f, 0.f};
#pragma unroll
                for (int ks = 0; ks < 4; ++ks) { const bf16x8 af = *(const LAS bf16x8*)(Xl + (16 * tt + li) * XP + 32 * ks + 8 * g);
                    da = __builtin_amdgcn_mfma_f32_16x16x32_bf16(af, wa[ks], da, 0, 0, 0); dx = __builtin_amdgcn_mfma_f32_16x16x32_bf16(af, wx[ks], dx, 0, 0, 0); }
#pragma unroll
                for (int r = 0; r < 4; ++r) { const int tl = 16 * tt + 4 * g + r; const float xcv = bf2f(Xl[tl * XP + cl]);
                    const float rr = sigmoidf_(da[r] + ba), ii = sigmoidf_(dx[r] + bx);
                    const float a = fast_exp2(-sp8l2 * rr); const float u = __builtin_amdgcn_sqrtf(fmaxf(__builtin_fmaf(-a, a, 1.f), 0.f)) * (ii * xcv);
                    if (r == 0) { pa[tt][0] = a; pb[tt][0] = u; } else { pa[tt][r] = a * pa[tt][r - 1]; pb[tt][r] = a * pb[tt][r - 1] + u; } }
            }
            float ea[8], eb[8], Ta[8], Tb[8];
#pragma unroll
            for (int tt = 0; tt < 8; ++tt) {
                float sa = pa[tt][3], sb = pb[tt][3];
                { const float ta = __shfl_up(sa, 16), tb = __shfl_up(sb, 16); if (g >= 1) { sb = sa * tb + sb; sa = ta * sa; } }
                { const float ta = __shfl_up(sa, 32), tb = __shfl_up(sb, 32); if (g >= 2) { sb = sa * tb + sb; sa = ta * sa; } }
                float e0 = __shfl_up(sa, 16), e1 = __shfl_up(sb, 16); if (g == 0) { e0 = 1.f; e1 = 0.f; }
                ea[tt] = e0; eb[tt] = e1; Ta[tt] = __shfl(sa, 48 + li); Tb[tt] = __shfl(sb, 48 + li);
            }
#pragma unroll
            for (int tt = 0; tt < 8; ++tt) {
                const float hg = ea[tt] * hc + eb[tt];
                hc = Ta[tt] * hc + Tb[tt];
#pragma unroll
                for (int r = 0; r < 4; ++r) { const int tl = 16 * tt + 4 * g + r; const float h = pa[tt][r] * hg + pb[tt][r];
                    const float yv = bf2f(Yl[tl * XP + cl]); Yl[tl * XP + cl] = f2bf(h * gelu_tanh(yv)); }
            }
        }
        __syncthreads();
#pragma unroll
        for (int p = 0; p < 4; ++p) { const int row = rbase + 32 * p; const u32x4 ov = *(const LAS u32x4*)(Yl + row * XP + 8 * ch); if (STORE) *(u32x4*)(Y + (tok0 + row) * 1024 + 128 * n + 8 * ch) = ov; else asm volatile("" :: "v"(ov.x), "v"(ov.y), "v"(ov.z), "v"(ov.w)); }
    }
}


#define XB_TMO      128
#define XB_XCNT(j)  (256  + 64 * (j))
#define XB_XSUB(j)  (1280 + 64 * (j))
#define XB_XGEN(j)  (2304 + 64 * (j))
#define XB_TOP      3328
#define XB_TOPGEN   3392
#define XCD_BAR_WORDS 3456
#define XB_SPIN_CAP (1u << 18)
__device__ __forceinline__ unsigned xb_ld(unsigned* p)              { return __hip_atomic_load(p, __ATOMIC_RELAXED, __HIP_MEMORY_SCOPE_AGENT); }
__device__ __forceinline__ unsigned xb_add(unsigned* p, unsigned v) { return __hip_atomic_fetch_add(p, v, __ATOMIC_RELAXED, __HIP_MEMORY_SCOPE_AGENT); }
__device__ __forceinline__ unsigned xb_xcc_id() { return (unsigned)__builtin_amdgcn_s_getreg((3 << 11) | 20) & 0xFu; }
#define XB_SPIN(cond, bar) do { unsigned _sp = 0; while (cond) { __builtin_amdgcn_s_sleep(1); \
    if ((++_sp & 255u) == 0u) { if (xb_ld(&(bar)[XB_TMO])) break; if (_sp > XB_SPIN_CAP) { atomicAdd(&(bar)[XB_TMO], 1u); break; } } } } while (0)
struct XcdBarrier { unsigned* bar; unsigned x; volatile LAS unsigned* st; };
__device__ __forceinline__ XcdBarrier xcd_barrier_post(unsigned* bar, volatile LAS unsigned* st) {
    XcdBarrier b; b.bar = bar; b.x = xb_xcc_id(); b.st = st;
    if (threadIdx.x == 0) (void)xb_add(&bar[XB_XCNT(b.x)], 1u);
    return b;
}
__device__ __forceinline__ void xcd_barrier_complete(unsigned* bar, unsigned x, unsigned& nloc, unsigned& nx) {
    const unsigned G = gridDim.x * gridDim.y * gridDim.z;
    unsigned sum, cnt, mine, sp = 0u;
    for (;;) {
        sum = 0u; cnt = 0u; mine = 0u;
#pragma unroll
        for (unsigned j = 0; j < 16; ++j) { const unsigned c = xb_ld(&bar[XB_XCNT(j)]); sum += c; cnt += (c > 0u) ? 1u : 0u; mine = (j == x) ? c : mine; }
        if (sum == G) break;
        __builtin_amdgcn_s_sleep(1);
        if ((++sp & 255u) == 0u) { if (xb_ld(&bar[XB_TMO])) break; if (sp > XB_SPIN_CAP) { atomicAdd(&bar[XB_TMO], 1u); break; } }
    }
    nloc = mine > 0u ? mine : 1u; nx = cnt > 0u ? cnt : 1u;
}
__device__ __forceinline__ void xcd_barrier(const XcdBarrier& b) {
    asm volatile("s_waitcnt vmcnt(0)" ::: "memory");
    __syncthreads();
    if (threadIdx.x == 0) {
        unsigned* bar = b.bar;
        __builtin_amdgcn_s_waitcnt(0);
        unsigned nloc = b.st[0], nx = b.st[1];
        if (nloc == 0u) { xcd_barrier_complete(bar, b.x, nloc, nx); b.st[0] = nloc; b.st[1] = nx; }
        const unsigned old = xb_add(&bar[XB_XSUB(b.x)], 1u);
        const unsigned gen = old / nloc;
        if (old + 1u == (gen + 1u) * nloc) {
            __builtin_amdgcn_fence(__ATOMIC_RELEASE, "agent");
            asm volatile("s_waitcnt vmcnt(0)" ::: "memory");
            const unsigned og = xb_add(&bar[XB_TOP], 1u);
            const unsigned tg = og / nx;
            if (og + 1u == (tg + 1u) * nx) xb_add(&bar[XB_TOPGEN], 1u);
            else XB_SPIN(xb_ld(&bar[XB_TOPGEN]) == tg, bar);
            __builtin_amdgcn_fence(__ATOMIC_ACQUIRE, "agent");
            xb_add(&bar[XB_XGEN(b.x)], 1u);
            asm volatile("s_waitcnt vmcnt(0)" ::: "memory");
        } else {
            XB_SPIN(xb_ld(&bar[XB_XGEN(b.x)]) == gen, bar);
            __builtin_amdgcn_fence(__ATOMIC_ACQUIRE, "agent");
            asm volatile("s_waitcnt vmcnt(0)" ::: "memory");
        }
    }
    __syncthreads();
}
__device__ __forceinline__ const float* ldptr(LAS unsigned long long* PT, int i) { const unsigned long long v = PT[i];
    const unsigned lo = __builtin_amdgcn_readfirstlane((unsigned)v), hi = __builtin_amdgcn_readfirstlane((unsigned)(v >> 32)); return (const float*)(((unsigned long long)hi << 32) | lo); }
constexpr int NWAVES = 8;
constexpr int LDS_BYTES = 147456;
constexpr int MISC_OFF = 143360;
struct Args { const float* in[35]; float* out; unsigned char* ws; };

#define CONV(Wsrc, Kd, Nd, WTdst, mode, roff) { const int ni_ = ((Kd) / 64) * ((Nd) / 32); if (r >= 0) { if (r < ni_) { transpose_item((Wsrc), (Kd), (Nd), (WTdst), (mode), (roff), scr, r, lane); r = -1; } else r -= ni_; } }

__global__ void __launch_bounds__(NWAVES * 64) fwd_megakernel(Args args) {
    extern __shared__ __attribute__((aligned(16))) unsigned char lds_raw[];
    cg::grid_group grid = cg::this_grid();
    LAS unsigned char* lds = (LAS unsigned char*)lds_raw;
    volatile LAS unsigned* MISC = (volatile LAS unsigned*)(lds + MISC_OFF);
    const int wave = __builtin_amdgcn_readfirstlane((int)threadIdx.x >> 6);
    const int G = gridDim.x, bx = blockIdx.x;
    const int gw = bx * NWAVES + wave, NGW = G * NWAVES;
#define CG_SYNC() do { asm volatile("s_waitcnt vmcnt(0) lgkmcnt(0)" ::: "memory"); grid.sync(); \
        if (wave == 0) { __builtin_amdgcn_fence(__ATOMIC_ACQUIRE, "agent"); asm volatile("s_waitcnt vmcnt(0)" ::: "memory"); } __syncthreads(); } while (0)
#define GRID_SYNC() xcd_barrier(xbar)
#define FRESH() int tid = threadIdx.x; asm volatile("" : "+v"(tid)); const int lane = tid & 63; (void)lane
    LAS unsigned long long* PT = (LAS unsigned long long*)(lds + MISC_OFF + 64);
    unsigned* barw = (unsigned*)(args.ws + WS_CTL) + 1024;
    { FRESH();
    if (tid < 35) PT[tid] = (unsigned long long)args.in[tid];
    if (tid < 16) MISC[tid] = 0u;
    if (bx == 0) { for (int i = tid; i < XCD_BAR_WORDS; i += NWAVES * 64) __hip_atomic_store(barw + i, 0u, __ATOMIC_RELAXED, __HIP_MEMORY_SCOPE_AGENT);
        for (int i = tid; i < 5 * 64; i += NWAVES * 64) __hip_atomic_store((unsigned*)(args.ws + WS_CTL) + CW_CNT + (i / 64) * 4096 + 64 * (i % 64), 0u, __ATOMIC_RELAXED, __HIP_MEMORY_SCOPE_AGENT);
        if (tid == 0) __hip_atomic_store((unsigned*)(args.ws + WS_CTL) + 2, 0u, __ATOMIC_RELAXED, __HIP_MEMORY_SCOPE_AGENT); } }
    __syncthreads();
#define IN(i) ldptr(PT, (i))
    unsigned char* ws = args.ws;
    const float* x = args.in[0];
    float* out = args.out;
    bf16_t* Hb = (bf16_t*)(ws + WS_H);
    LAS float* scr = (LAS float*)(lds + wave * 16384);
    CG_SYNC();
    const XcdBarrier xbar = xcd_barrier_post(barw, MISC + 8);

    {
        FRESH();
        if (bx == 0 && tid == 0) { atomicExch((unsigned*)(ws + WS_CTL), 0u); atomicExch((unsigned*)(ws + WS_CTL) + 64, 0u); }
        constexpr int NIT = 2 * 1408 + 512 + 1024 + 16 * 8;
        for (int it = gw; it < NIT; it += NGW) {
            int r = it;
            CONV(IN(3), 1024, DFF, (bf16_t*)(ws + WS_WGU), 1, 0);
            CONV(IN(4), 1024, DFF, (bf16_t*)(ws + WS_WGU), 1, 128);
            CONV(IN(28), 1024, 1024, (bf16_t*)(ws + WS_WMIX), 0, 0);
            CONV(IN(24), 1024, 2048, (bf16_t*)(ws + WS_WKV), 0, 0);
            if (r >= 0) { const int mat = r >> 3, sub = r & 7; const float* src = (mat < 8 ? IN(17) + (size_t)mat * 16384 : IN(19) + (size_t)(mat - 8) * 16384);
              transpose_item(src, 128, 128, (bf16_t*)(ws + WS_WLRU) + (size_t)mat * 16384, 0, 0, scr, sub, lane); }
        }
        { int m = gw;
          for (; m + NGW < T; m += 2 * NGW) rms_row2_to_bf16(x + (size_t)m * D, x + (size_t)(m + NGW) * D, IN(2), Hb + (size_t)m * D, Hb + (size_t)(m + NGW) * D, lane);
          if (m < T) rms_row_to_bf16(x + (size_t)m * D, IN(2), Hb + (size_t)m * D, lane); }
        for (int m = gw; m < NB * NMEM; m += NGW) rms_row_to_bf16(IN(1) + (size_t)m * D, IN(23), (bf16_t*)(ws + WS_MEMN) + (size_t)m * D, lane);
    }
    GRID_SYNC();


    {
        pg8::SchedTwo S{(const char*)Hb, (const char*)(ws + WS_WGU), (const char*)(ws + WS_MEMN), (const char*)(ws + WS_WKV), 1024, 64, 22, 8, 8, G, bx};
        pg8::EpiSwigluKv E{(bf16_t*)(ws + WS_ACT1), (bf16_t*)(ws + WS_KVM), 2048};
        pg8::gemm_phase(lds, 1024, S, E);
        const int nfull = (64 * 22 + 64) % G;
        const int nhelp = (nfull == 0) ? G : G - nfull, hidx = (nfull == 0) ? bx : bx - nfull;
        if (hidx >= 0) {
            FRESH();
            constexpr int NIT = 1408 + 3072;
            for (int it = hidx * NWAVES + wave; it < NIT; it += nhelp * NWAVES) {
                int r = it;
                CONV(IN(5), DFF, 1024, (bf16_t*)(ws + WS_WD), 0, 0);
                if (r >= 0) transpose_item(IN(8), 1024, 6144, (bf16_t*)(ws + WS_WIN), 0, 0, scr, r, lane);
            }
        }
    }
    GRID_SYNC();
    {
        unsigned* ctl = (unsigned*)(ws + WS_CTL);
        pg8::SchedPlain S{(const char*)(ws + WS_ACT1), (const char*)(ws + WS_WD), DFF, 64, 4, G, bx};
        pg8::RmsExchange st1{(unsigned*)(ws + WS_XSLOT), ctl + CW_CNT + 0 * 4096, ctl + 2}, st2{(unsigned*)(ws + WS_XSLOT) + 65536, ctl + CW_CNT + 1 * 4096, ctl + 2};
        pg8::EpiRmsRes<true> E{x, out, Hb, IN(6), IN(7), 0.5f, st1, st2};
        pg8::gemm_phase(lds, DFF, S, E);
    }
    GRID_SYNC();
    {
        pg8::SchedPlain S{(const char*)Hb, (const char*)(ws + WS_WIN), 1024, 64, 24, G, bx};
        pg8::EpiSplitBf16 E{(bf16_t*)(ws + WS_SQ), (size_t)T * 1024};
        pg8::gemm_phase(lds, 1024, S, E);
    }
    GRID_SYNC();
    {
        FRESH();
        constexpr int NIT = 3 * 512 + 1536;
        for (int it = gw; it < NIT; it += NGW) {
            int r = it;
            CONV(IN(14), 1024, 1024, (bf16_t*)(ws + WS_W3), 0, 0);
            CONV(IN(22), 1024, 1024, (bf16_t*)(ws + WS_W3), 0, 1024);
            CONV(IN(25), 1024, 1024, (bf16_t*)(ws + WS_W3), 0, 2048);
            if (r >= 0) transpose_item(IN(26), 1024, 3072, (bf16_t*)(ws + WS_WBG), 0, 0, scr, r, lane);
        }
        float lamv;
        { float s1 = 0.f, s2 = 0.f;
          s1 = wave_sum(IN(9)[lane] * IN(10)[lane]); s2 = wave_sum(IN(11)[lane] * IN(12)[lane]);
          lamv = __uint_as_float(__builtin_amdgcn_readfirstlane(__float_as_uint(expf(s1) - expf(s2) + 0.2f))); }
        unsigned* ctr = (unsigned*)(ws + WS_CTL);
        constexpr int NU_LRU = 64, NU_DA = 1024, NU_CA = 512, NU = NU_LRU + NU_DA;
        for (;;) {
            __syncthreads();
            if (threadIdx.x == 0) MISC[0] = atomicAdd(ctr, 1u);
            __syncthreads();
            const unsigned uu = MISC[0];
            if (uu >= (unsigned)NU) break;
            const int u = (int)uu;
            if (u < NU_LRU) {
                lru_unit<true>(lds, u >> 3, u & 7, (const bf16_t*)(ws + WS_SX), (bf16_t*)(ws + WS_SY), (const bf16_t*)(ws + WS_WLRU), IN(15), IN(16), IN(18), IN(20), IN(21));
            } else {
                const int j = u - NU_LRU, qb = 15 - (j >> 6), bh = j & 63, b = bh >> 3, h = bh & 7;
                const size_t rowb = (size_t)b * SEQ;
                bf16_t* Q = (bf16_t*)(ws + WS_SQ) + (rowb + 128 * qb) * 1024 + h * 128;
                const bf16_t* Kp = (const bf16_t*)(ws + WS_SK) + rowb * 1024 + h * 128;
                const bf16_t* Vp = (const bf16_t*)(ws + WS_SV) + rowb * 1024 + h * 128;
                const float slope = exp2f(-(float)(h + 1));
                attn_unit<2, 64, 128, true>(lds, Q, Kp, 1024, Vp, 1024, Q, 1024, 128 * qb, 2 * (qb + 1), 0.125f * LOG2E, slope * LOG2E, lamv, IN(13));
            }
        }
        for (;;) {
            __syncthreads();
            if (threadIdx.x == 0) MISC[0] = atomicAdd(ctr + 64, 1u);
            __syncthreads();
            const unsigned uu = MISC[0];
            if (uu >= (unsigned)NU_CA) break;
            {
                const int j = (int)uu, qb = j >> 5, bh = j & 31, b = bh >> 2, h = bh & 3;
                bf16_t* Q = (bf16_t*)(ws + WS_SQC) + ((size_t)b * SEQ + 128 * qb) * 1024 + h * 256;
                const bf16_t* Kp = (const bf16_t*)(ws + WS_KVM) + (size_t)b * NMEM * 2048 + h * 256;
                const bf16_t* Vp = Kp + 1024;
                attn_unit<1, 256, 256, false>(lds, Q, Kp, 2048, Vp, 2048, Q, 1024, 0, 4, 0.0625f * LOG2E, 0.f, 0.f, IN(13));
            }
        }
    }
    GRID_SYNC();
    {
        pg8::SchedMerge S{(const char*)Hb, (const char*)(ws + WS_WBG), (const char*)(ws + WS_SQ), (const char*)(ws + WS_SY), (const char*)(ws + WS_SQC), (const char*)(ws + WS_W3), G, bx};
        pg8::EpiMerge E{(u32x4*)(ws + WS_GSCR) + (size_t)bx * 16 * 512, IN(27), (bf16_t*)(ws + WS_MERGED)};
        pg8::gemm_phase(lds, 1024, S, E);
    }
    GRID_SYNC();
    {
        {
            FRESH();
            constexpr int NIT = 3 * 1408;
            for (int it = gw; it < NIT; it += NGW) {
                int r = it;
                CONV(IN(31), 1024, DFF, (bf16_t*)(ws + WS_WGU), 1, 0);
                CONV(IN(32), 1024, DFF, (bf16_t*)(ws + WS_WGU), 1, 128);
                if (r >= 0) transpose_item(IN(33), DFF, 1024, (bf16_t*)(ws + WS_WD), 0, 0, scr, r, lane);
            }
            __syncthreads();
        }
        unsigned* ctl = (unsigned*)(ws + WS_CTL);
        pg8::SchedPlain S{(const char*)(ws + WS_MERGED), (const char*)(ws + WS_WMIX), 1024, 64, 4, G, bx};
        pg8::RmsExchange st1{(unsigned*)(ws + WS_XSLOT), ctl + CW_CNT + 2 * 4096, ctl + 2}, st2{(unsigned*)(ws + WS_XSLOT) + 65536, ctl + CW_CNT + 3 * 4096, ctl + 2};
        pg8::EpiRmsRes<true> E{out, out, Hb, IN(29), IN(30), 1.0f, st1, st2};
        pg8::gemm_phase(lds, 1024, S, E);
    }
    GRID_SYNC();
    {
        pg8::SchedTwo S{(const char*)Hb, (const char*)(ws + WS_WGU), (const char*)Hb, (const char*)(ws + WS_WGU), 1024, 64, 22, 0, 0, G, bx};
        pg8::EpiSwigluKv E{(bf16_t*)(ws + WS_ACT2), (bf16_t*)(ws + WS_ACT2), 2048};
        pg8::gemm_phase(lds, 1024, S, E);
    }
    GRID_SYNC();
    {
        unsigned* ctl = (unsigned*)(ws + WS_CTL);
        pg8::SchedPlain S{(const char*)(ws + WS_ACT2), (const char*)(ws + WS_WD), DFF, 64, 4, G, bx};
        pg8::RmsExchange st1{(unsigned*)(ws + WS_XSLOT), ctl + CW_CNT + 4 * 4096, ctl + 2};
        pg8::EpiRmsRes<false> E{out, out, nullptr, IN(34), nullptr, 0.5f, st1, st1};
        pg8::gemm_phase(lds, DFF, S, E);
    }
}

extern "C" void kernel_launch(void* const* d_in, const int* in_sizes, int n_in, void* d_out, int out_size, void* d_ws, size_t ws_size, hipStream_t stream) {
    static int grid = 0;
    if (grid == 0) {
        if (n_in != 35 || ws_size < WS_END) { fprintf(stderr, "kernel_launch: unexpected inputs (n_in %d, ws %zu)\n", n_in, ws_size); grid = -1; return; }
        int dev = 0, cus = 0, per_cu = 0;
        hipGetDevice(&dev);
        hipDeviceGetAttribute(&cus, hipDeviceAttributeMultiprocessorCount, dev);
        hipFuncSetAttribute((const void*)fwd_megakernel, hipFuncAttributeMaxDynamicSharedMemorySize, LDS_BYTES);
        hipOccupancyMaxActiveBlocksPerMultiprocessor(&per_cu, (const void*)fwd_megakernel, NWAVES * 64, LDS_BYTES);
        if (per_cu < 1) per_cu = 1;
        grid = cus > 256 ? 256 : cus;
        (void)hipGetLastError();
    }
    if (grid < 0) return;
    Args a{};
    for (int i = 0; i < 35; ++i) a.in[i] = (const float*)d_in[i];
    a.out = (float*)d_out; a.ws = (unsigned char*)d_ws;
    void* kargs[] = {&a};
    hipError_t e = hipLaunchCooperativeKernel((const void*)fwd_megakernel, dim3(grid), dim3(NWAVES * 64), kargs, LDS_BYTES, stream);
    if (e != hipSuccess) fprintf(stderr, "cooperative launch failed: %s (grid %d)\n", hipGetErrorString(e), grid);
}
```

```cpp
#include <hip/hip_runtime.h>
#include <hip/hip_cooperative_groups.h>
#include <cstdio>
#include <cstdint>
namespace cg = cooperative_groups;

#define LAS __attribute__((address_space(3)))
typedef unsigned short bf16_t;
typedef short bf16x8 __attribute__((ext_vector_type(8)));
typedef short s16x4 __attribute__((ext_vector_type(4)));
typedef float f32x4 __attribute__((ext_vector_type(4)));
typedef float f32x2 __attribute__((ext_vector_type(2)));
typedef unsigned u32x4 __attribute__((ext_vector_type(4)));
typedef unsigned u32x2 __attribute__((ext_vector_type(2)));

constexpr int T = 16384, D = 1024, SEQ = 2048, NB = 8, DFF = 2816, NMEM = 256;
constexpr float EPS = 1e-6f;
constexpr float LOG2E = 1.4426950408889634f;

constexpr size_t MiB = 1u << 20;
constexpr size_t WS_CTL = 0;
constexpr size_t WS_WLRU = 1 * MiB;
constexpr size_t WS_KVM = 2 * MiB;
constexpr size_t WS_MEMN = 10 * MiB;
constexpr size_t WS_WKV = 14 * MiB;
constexpr size_t WS_WIN = 18 * MiB;
constexpr size_t WS_W3 = 18 * MiB, WS_WBG = 24 * MiB;
constexpr size_t WS_WMIX = 30 * MiB;
constexpr size_t WS_H = 32 * MiB;
constexpr size_t WS_BIG = 64 * MiB;
constexpr size_t WS_WGU = 64 * MiB;
constexpr size_t WS_WD = 75 * MiB;
constexpr size_t WS_ACT1 = 84 * MiB;
constexpr size_t SLOT = 32 * MiB;
constexpr size_t WS_SQ = 64 * MiB, WS_SK = 96 * MiB, WS_SV = 128 * MiB, WS_SX = 160 * MiB, WS_SY = 192 * MiB, WS_SQC = 224 * MiB;
constexpr size_t WS_GSCR = 96 * MiB;
constexpr size_t WS_MERGED = 160 * MiB;
constexpr size_t WS_ACT2 = 160 * MiB;
constexpr size_t WS_XSLOT = 1 * MiB + 512 * 1024;
constexpr int CW_CNT = 8192;
constexpr size_t WS_END = 256 * MiB;

typedef __bf16 bf16x2_t __attribute__((ext_vector_type(2)));
__device__ __forceinline__ unsigned cvt_pk_bf16(float lo, float hi) { const f32x2 v = {lo, hi}; const bf16x2_t b = __builtin_convertvector(v, bf16x2_t); return __builtin_bit_cast(unsigned, b); }
__device__ __forceinline__ float bf_lo(unsigned u) { return __uint_as_float(u << 16); }
__device__ __forceinline__ float bf_hi(unsigned u) { return __uint_as_float(u & 0xffff0000u); }
__device__ __forceinline__ float bf2f(bf16_t v) { return __uint_as_float(((unsigned)v) << 16); }
__device__ __forceinline__ bf16_t f2bf(float f) { return (bf16_t)(cvt_pk_bf16(f, 0.f) & 0xffffu); }
__device__ __forceinline__ float fast_rcp(float x) { return __builtin_amdgcn_rcpf(x); }
__device__ __forceinline__ float fast_exp2(float x) { return __builtin_amdgcn_exp2f(x); }
__device__ __forceinline__ float sigmoidf_(float x) { return fast_rcp(1.f + fast_exp2(-x * LOG2E)); }
__device__ __forceinline__ float xmax16(float v) { auto r = __builtin_amdgcn_permlane16_swap(__float_as_uint(v), __float_as_uint(v), false, false); return fmaxf(__uint_as_float(r[0]), __uint_as_float(r[1])); }
__device__ __forceinline__ float xmax32(float v) { auto r = __builtin_amdgcn_permlane32_swap(__float_as_uint(v), __float_as_uint(v), false, false); return fmaxf(__uint_as_float(r[0]), __uint_as_float(r[1])); }
__device__ __forceinline__ float xsum16(float v) { auto r = __builtin_amdgcn_permlane16_swap(__float_as_uint(v), __float_as_uint(v), false, false); return __uint_as_float(r[0]) + __uint_as_float(r[1]); }
__device__ __forceinline__ float xsum32(float v) { auto r = __builtin_amdgcn_permlane32_swap(__float_as_uint(v), __float_as_uint(v), false, false); return __uint_as_float(r[0]) + __uint_as_float(r[1]); }
__device__ __forceinline__ float wave_sum(float v) {
#pragma unroll
    for (int o = 1; o < 64; o <<= 1) v += __shfl_xor(v, o);
    return v;
}

namespace pg8 {
constexpr int BM = 256, BK = 64, HALF = 128, HTB = HALF * BK * 2, STAGE_BYTES = 8 * HTB, NXCD = 8, WGM = 8;
__host__ __device__ __forceinline__ int lds_byte(int r, int c) { const int st = (r >> 4) * 2 + (c >> 5), rr = r & 15, cc = c & 31, ob = rr * 64 + cc * 2; return st * 1024 + (ob ^ (((ob >> 9) & 1) << 5)); }
__host__ __device__ __forceinline__ void stage_rc(int b, int& R, int& C) { const int st = b / 1024, sb = b % 1024, swz = sb ^ (((sb >> 9) & 1) << 5); R = (st >> 1) * 16 + swz / 64; C = (st & 1) * 32 + (swz % 64) / 2; }
__host__ __device__ __forceinline__ int perm32(int rho) { const int n = rho >> 4, i = rho & 15; return 8 * (i >> 2) + 4 * n + (i & 3); }

struct Unit { int pm, pn, kind; };

__device__ __forceinline__ void tile_of(int L, int nM, int nN, int& pm, int& pn) {
    const int nwg = nM * nN;
    int wgid = L; { const int q = nwg / NXCD, r = nwg % NXCD, xcd = wgid % NXCD, off = wgid / NXCD; wgid = (xcd < r ? xcd * (q + 1) : r * (q + 1) + (xcd - r) * q) + off; }
    const int nig = WGM * nN, gid = wgid / nig, fm = gid * WGM, gsz = (nM - fm) < WGM ? (nM - fm) : WGM;
    pm = fm + ((wgid % nig) % gsz); pn = (wgid % nig) / gsz;
}

template <class Epi, class Sched>
__device__ __forceinline__ void gemm_phase(LAS unsigned char* lds, const int K, const Sched& S, const Epi& E) {
    int tid = threadIdx.x; asm volatile("" : "+v"(tid));
    const int wid = __builtin_amdgcn_readfirstlane(tid >> 6), lane = tid & 63, wr = wid >> 2, wc = wid & 3, fr = lane & 15, fq = lane >> 4;
    const int nt = K / BK;
    unsigned voffA[2], voffB[2];
#pragma unroll
    for (int i = 0; i < 2; ++i) { int R, C; stage_rc(tid * 16 + i * 8192, R, C); const int Rb = Epi::PERM ? ((R & ~31) + perm32(R & 31)) : R;
        voffA[i] = (unsigned)(R * K + C) * 2u; voffB[i] = (unsigned)(Rb * K + C) * 2u; }
    const size_t kstep = (size_t)(BK * 2);
    const size_t hstep = (size_t)HALF * K * 2;
    const unsigned ldsw = (unsigned)wid * 1024u;
    const int aoff = lds_byte(wr * 64 + fr, fq * 8), boff = lds_byte(wc * 32 + fr, fq * 8);
#define PG8_SA(b, h) (((b) * 2 + (h)) * HTB)
#define PG8_SB(b, h) ((4 + (b) * 2 + (h)) * HTB)
#define PG8_STAGE(bufoff, gbase, voff) do { _Pragma("unroll") for (int _i = 0; _i < 2; ++_i) \
        __builtin_amdgcn_global_load_lds((const unsigned*)((const char*)(gbase) + (voff)[_i]), (LAS unsigned*)(lds + (bufoff) + ldsw + _i * 8192), 16, 0, 0); } while (0)
#define PG8_LDA(dst, b, h) do { _Pragma("unroll") for (int m = 0; m < 4; ++m) _Pragma("unroll") for (int k = 0; k < 2; ++k) dst[m][k] = *(const LAS bf16x8*)(lds + PG8_SA(b, h) + aoff + m * 2048 + k * 1024); } while (0)
#define PG8_LDB(dst, b, h) do { _Pragma("unroll") for (int n = 0; n < 2; ++n) _Pragma("unroll") for (int k = 0; k < 2; ++k) dst[n][k] = *(const LAS bf16x8*)(lds + PG8_SB(b, h) + boff + n * 2048 + k * 1024); } while (0)
#define PG8_MMA(ai, bj, At, Bt) do { __builtin_amdgcn_s_setprio(1); _Pragma("unroll") for (int m = 0; m < 4; ++m) _Pragma("unroll") for (int n = 0; n < 2; ++n) _Pragma("unroll") for (int k = 0; k < 2; ++k) \
        acc[ai][bj][m][n] = __builtin_amdgcn_mfma_f32_16x16x32_bf16(Bt[n][k], At[m][k], acc[ai][bj][m][n], 0, 0, 0); __builtin_amdgcn_s_setprio(0); } while (0)
#define PG8_WAIT_V(n) asm volatile("s_waitcnt vmcnt(" #n ")" ::: "memory")
#define PG8_WAIT_L(n) asm volatile("s_waitcnt lgkmcnt(" #n ")" ::: "memory")
#define PG8_BAR __builtin_amdgcn_s_barrier()
#define PG8_SCHED __builtin_amdgcn_sched_barrier(0)
    Unit cur, nxt; int ui = 0;
    if (!S.next(0, cur)) return;
    f32x4 acc[2][2][4][2];
#pragma unroll
    for (int a = 0; a < 2; ++a)
#pragma unroll
        for (int b = 0; b < 2; ++b)
#pragma unroll
            for (int m = 0; m < 4; ++m)
#pragma unroll
                for (int n = 0; n < 2; ++n) acc[a][b][m][n] = (f32x4){0.f, 0.f, 0.f, 0.f};
    bf16x8 At[4][2], B0[2][2], B1[2][2];
    const char* cA = S.a_ptr(cur); const char* cB = S.b_ptr(cur);
    PG8_STAGE(PG8_SB(0, 0), cB, voffB); PG8_STAGE(PG8_SB(0, 1), cB + hstep, voffB); PG8_STAGE(PG8_SA(0, 0), cA, voffA); PG8_STAGE(PG8_SA(0, 1), cA + hstep, voffA);
    if (wr == 1) PG8_BAR;
    PG8_WAIT_V(2); PG8_BAR;
    PG8_STAGE(PG8_SB(1, 0), cB + kstep, voffB); PG8_STAGE(PG8_SA(1, 0), cA + kstep, voffA); PG8_STAGE(PG8_SB(1, 1), cB + hstep + kstep, voffB);
    PG8_WAIT_V(6); PG8_BAR;
    for (;;) {
        const bool has_next = S.next(ui + 1, nxt);
        const char* nA = has_next ? S.a_ptr(nxt) : cA; const char* nB = has_next ? S.b_ptr(nxt) : cB;
        for (int t = 0; t < nt; t += 2) {
            const bool last = (t == nt - 2);
            const char* a1 = cA + (size_t)(t + 1) * kstep;
            const char* a2 = last ? nA : cA + (size_t)(t + 2) * kstep; const char* b2 = last ? nB : cB + (size_t)(t + 2) * kstep;
            const char* a3 = a2 + kstep; const char* b3 = b2 + kstep;
            PG8_LDB(B0, 0, 0); PG8_LDB(B1, 0, 1); PG8_SCHED; PG8_LDA(At, 0, 0); PG8_STAGE(PG8_SA(1, 1), a1 + hstep, voffA);
            PG8_WAIT_V(8); PG8_WAIT_L(0); PG8_BAR; PG8_MMA(0, 0, At, B0); PG8_MMA(0, 1, At, B1); PG8_BAR; PG8_SCHED;
            PG8_LDA(At, 0, 1); PG8_STAGE(PG8_SB(0, 0), b2, voffB); PG8_STAGE(PG8_SB(0, 1), b2 + hstep, voffB); PG8_STAGE(PG8_SA(0, 0), a2, voffA);
            PG8_WAIT_V(8); PG8_WAIT_L(0); PG8_BAR; PG8_MMA(1, 0, At, B0); PG8_MMA(1, 1, At, B1); PG8_BAR; PG8_SCHED;
            PG8_LDB(B0, 1, 0); PG8_LDB(B1, 1, 1); PG8_SCHED; PG8_LDA(At, 1, 0); PG8_STAGE(PG8_SA(0, 1), a2 + hstep, voffA);
            PG8_WAIT_V(8); PG8_WAIT_L(0); PG8_BAR; PG8_MMA(0, 0, At, B0); PG8_MMA(0, 1, At, B1); PG8_BAR; PG8_SCHED;
            PG8_LDA(At, 1, 1); PG8_STAGE(PG8_SB(1, 0), b3, voffB); PG8_STAGE(PG8_SB(1, 1), b3 + hstep, voffB); PG8_STAGE(PG8_SA(1, 0), a3, voffA);
            PG8_WAIT_V(8); PG8_WAIT_L(0); PG8_BAR; PG8_MMA(1, 0, At, B0); PG8_MMA(1, 1, At, B1); PG8_BAR; PG8_SCHED;
        }
        if (wr == 0) PG8_BAR;
        if constexpr (!Epi::AFTER_DRAIN) E(acc, cur, wr, wc, fr, fq);
        if (!has_next) break;
#pragma unroll
        for (int a = 0; a < 2; ++a)
#pragma unroll
            for (int b = 0; b < 2; ++b)
#pragma unroll
                for (int m = 0; m < 4; ++m)
#pragma unroll
                    for (int n = 0; n < 2; ++n) acc[a][b][m][n] = (f32x4){0.f, 0.f, 0.f, 0.f};
        cur = nxt; cA = nA; cB = nB; ++ui;
        if (wr == 1) PG8_BAR;
    }
    PG8_WAIT_V(0);
    PG8_BAR;
    if constexpr (Epi::AFTER_DRAIN) E.fused(acc, cur, wr, wc, fr, fq, lds, wid, lane);
#undef PG8_SA
#undef PG8_SB
#undef PG8_STAGE
#undef PG8_LDA
#undef PG8_LDB
#undef PG8_MMA
#undef PG8_WAIT_V
#undef PG8_WAIT_L
#undef PG8_BAR
#undef PG8_SCHED
}

struct SchedPlain {
    const char* A; const char* Bt; int K, nM, nN, G, c;
    __device__ __forceinline__ bool next(int i, Unit& u) const { const long L = (long)i * G + c; if (L >= (long)nM * nN) return false; tile_of((int)L, nM, nN, u.pm, u.pn); u.kind = 0; return true; }
    __device__ __forceinline__ const char* a_ptr(const Unit& u) const { return A + (size_t)u.pm * BM * K * 2; }
    __device__ __forceinline__ const char* b_ptr(const Unit& u) const { return Bt + (size_t)u.pn * BM * K * 2; }
};
struct SchedTwo {
    const char* A0; const char* B0; const char* A1; const char* B1; int K, nM0, nN0, nM1, nN1, G, c;
    __device__ __forceinline__ bool next(int i, Unit& u) const {
        const long L = (long)i * G + c; const int n0 = nM0 * nN0;
        if (L < n0) { tile_of((int)L, nM0, nN0, u.pm, u.pn); u.kind = 0; return true; }
        const int j = (int)(L - n0); if (j >= nM1 * nN1) return false;
        u.pm = j / nN1; u.pn = j % nN1; u.kind = 1; return true; }
    __device__ __forceinline__ const char* a_ptr(const Unit& u) const { return (u.kind ? A1 : A0) + (size_t)u.pm * BM * K * 2; }
    __device__ __forceinline__ const char* b_ptr(const Unit& u) const { return (u.kind ? B1 : B0) + (size_t)u.pn * BM * K * 2; }
};
struct SchedMerge {
    const char* H; const char* Wbg; const char* O0; const char* O1; const char* O2; const char* W3; int G, c;
    __device__ __forceinline__ bool next(int i, Unit& u) const { const int t = (i / 6) * G + c; if (t >= 256) return false; tile_of(t, 64, 4, u.pm, u.pn); u.kind = i % 6; return true; }
    __device__ __forceinline__ const char* a_ptr(const Unit& u) const { const int b = u.kind >> 1; const char* base = (u.kind & 1) ? (b == 0 ? O0 : (b == 1 ? O1 : O2)) : H; return base + (size_t)u.pm * BM * 1024 * 2; }
    __device__ __forceinline__ const char* b_ptr(const Unit& u) const { const int b = u.kind >> 1; const char* base = (u.kind & 1) ? W3 : Wbg; return base + ((size_t)b * 1024 + (size_t)u.pn * BM) * 1024 * 2; }
};

struct EpiSwigluKv {
    static constexpr bool AFTER_DRAIN = false;
    static constexpr bool PERM = true;
    bf16_t* act; bf16_t* O1; int ldc1;
    __device__ __forceinline__ void operator()(const f32x4 (&acc)[2][2][4][2], const Unit& u, int wr, int wc, int fr, int fq) const {
        const int row0 = u.pm * BM + wr * 64 + fr;
        if (u.kind == 0) {
            const int col0 = u.pn * 128 + wc * 32 + 8 * fq;
#pragma unroll
            for (int ai = 0; ai < 2; ++ai)
#pragma unroll
                for (int m = 0; m < 4; ++m) {
                    bf16_t* rowp = act + (size_t)(row0 + ai * HALF + m * 16) * DFF + col0;
                    float o[8];
#pragma unroll
                    for (int n = 0; n < 2; ++n)
#pragma unroll
                        for (int j = 0; j < 4; ++j) { const float g = acc[ai][0][m][n][j], up = acc[ai][1][m][n][j]; o[n * 4 + j] = g * sigmoidf_(g) * up; }
                    u32x4 w; w.x = cvt_pk_bf16(o[0], o[1]); w.y = cvt_pk_bf16(o[2], o[3]); w.z = cvt_pk_bf16(o[4], o[5]); w.w = cvt_pk_bf16(o[6], o[7]);
                    *(u32x4*)rowp = w;
                }
        } else {
            const int col0 = u.pn * BM + wc * 32 + 8 * fq;
#pragma unroll
            for (int ai = 0; ai < 2; ++ai)
#pragma unroll
                for (int m = 0; m < 4; ++m) {
                    bf16_t* rowp = O1 + (size_t)(row0 + ai * HALF + m * 16) * ldc1 + col0;
#pragma unroll
                    for (int bj = 0; bj < 2; ++bj) { const f32x4 v0 = acc[ai][bj][m][0], v1 = acc[ai][bj][m][1];
                        u32x4 w; w.x = cvt_pk_bf16(v0[0], v0[1]); w.y = cvt_pk_bf16(v0[2], v0[3]); w.z = cvt_pk_bf16(v1[0], v1[1]); w.w = cvt_pk_bf16(v1[2], v1[3]);
                        *(u32x4*)(rowp + bj * HALF) = w; }
                }
        }
    }
};
struct EpiSplitBf16 {
    static constexpr bool AFTER_DRAIN = false;
    static constexpr bool PERM = true;
    bf16_t* O; size_t split_stride;
    __device__ __forceinline__ void operator()(const f32x4 (&acc)[2][2][4][2], const Unit& u, int wr, int wc, int fr, int fq) const {
        const int row0 = u.pm * BM + wr * 64 + fr; int colt = u.pn * BM; const int t = colt >> 10; colt &= 1023;
        bf16_t* base = O + (size_t)t * split_stride; const int col0 = colt + wc * 32 + 8 * fq;
#pragma unroll
        for (int ai = 0; ai < 2; ++ai)
#pragma unroll
            for (int m = 0; m < 4; ++m) {
                bf16_t* rowp = base + (size_t)(row0 + ai * HALF + m * 16) * 1024 + col0;
#pragma unroll
                for (int bj = 0; bj < 2; ++bj) { const f32x4 v0 = acc[ai][bj][m][0], v1 = acc[ai][bj][m][1];
                    u32x4 w; w.x = cvt_pk_bf16(v0[0], v0[1]); w.y = cvt_pk_bf16(v0[2], v0[3]); w.z = cvt_pk_bf16(v1[0], v1[1]); w.w = cvt_pk_bf16(v1[2], v1[3]);
                    *(u32x4*)(rowp + bj * HALF) = w; }
            }
    }
};
struct EpiMerge {
    static constexpr bool AFTER_DRAIN = false;
    static constexpr bool PERM = true;
    u32x4* gscr; const float* bias; bf16_t* merged;
    __device__ __forceinline__ void operator()(const f32x4 (&acc)[2][2][4][2], const Unit& u, int wr, int wc, int fr, int fq) const {
        const int b = u.kind >> 1; int tid = threadIdx.x; asm volatile("" : "+v"(tid));
        const int row0 = u.pm * BM + wr * 64 + fr, col0 = u.pn * BM + wc * 32 + 8 * fq;
        if ((u.kind & 1) == 0) {
#pragma unroll
            for (int bj = 0; bj < 2; ++bj) {
                const f32x4 b0 = *(const f32x4*)(bias + b * 1024 + col0 + bj * HALF), b1 = *(const f32x4*)(bias + b * 1024 + col0 + bj * HALF + 4);
#pragma unroll
                for (int ai = 0; ai < 2; ++ai)
#pragma unroll
                    for (int m = 0; m < 4; ++m) { const f32x4 v0 = acc[ai][bj][m][0] + b0, v1 = acc[ai][bj][m][1] + b1;
                        u32x4 w; w.x = cvt_pk_bf16(sigmoidf_(v0[0]), sigmoidf_(v0[1])); w.y = cvt_pk_bf16(sigmoidf_(v0[2]), sigmoidf_(v0[3]));
                        w.z = cvt_pk_bf16(sigmoidf_(v1[0]), sigmoidf_(v1[1])); w.w = cvt_pk_bf16(sigmoidf_(v1[2]), sigmoidf_(v1[3]));
                        gscr[((ai * 4 + m) * 2 + bj) * 512 + tid] = w; }
            }
        } else {
#pragma unroll
            for (int ai = 0; ai < 2; ++ai)
#pragma unroll
                for (int bj = 0; bj < 2; ++bj) {
                    u32x4 gw[4], old[4];
#pragma unroll
                    for (int m = 0; m < 4; ++m) gw[m] = gscr[((ai * 4 + m) * 2 + bj) * 512 + tid];
                    if (b != 0) {
#pragma unroll
                        for (int m = 0; m < 4; ++m) old[m] = *(const u32x4*)(merged + (size_t)(row0 + ai * HALF + m * 16) * 1024 + col0 + bj * HALF);
                    }
#pragma unroll
                    for (int m = 0; m < 4; ++m) {
                        const f32x4 v0 = acc[ai][bj][m][0], v1 = acc[ai][bj][m][1];
                        float o[8];
                        o[0] = bf_lo(gw[m].x) * v0[0]; o[1] = bf_hi(gw[m].x) * v0[1]; o[2] = bf_lo(gw[m].y) * v0[2]; o[3] = bf_hi(gw[m].y) * v0[3];
                        o[4] = bf_lo(gw[m].z) * v1[0]; o[5] = bf_hi(gw[m].z) * v1[1]; o[6] = bf_lo(gw[m].w) * v1[2]; o[7] = bf_hi(gw[m].w) * v1[3];
                        if (b != 0) {
                            o[0] += bf_lo(old[m].x); o[1] += bf_hi(old[m].x); o[2] += bf_lo(old[m].y); o[3] += bf_hi(old[m].y);
                            o[4] += bf_lo(old[m].z); o[5] += bf_hi(old[m].z); o[6] += bf_lo(old[m].w); o[7] += bf_hi(old[m].w); }
                        u32x4 w; w.x = cvt_pk_bf16(o[0], o[1]); w.y = cvt_pk_bf16(o[2], o[3]); w.z = cvt_pk_bf16(o[4], o[5]); w.w = cvt_pk_bf16(o[6], o[7]);
                        *(u32x4*)(merged + (size_t)(row0 + ai * HALF + m * 16) * 1024 + col0 + bj * HALF) = w;
                    }
                    asm volatile("" ::: "memory");
                }
        }
    }
};

struct RmsExchange {
    unsigned* xbuf;
    unsigned* cnt;
    unsigned* tmo;
    __device__ __forceinline__ void run(const f32x4 (&v)[2][2][4][2], const Unit& u, int wr, int wc, int fr, int fq, LAS unsigned char* lds, int wid, int lane) const {
        LAS float* P = (LAS float*)lds; LAS float* S = (LAS float*)(lds + 8192);
#pragma unroll
        for (int ai = 0; ai < 2; ++ai)
#pragma unroll
            for (int m = 0; m < 4; ++m) {
                float q = 0.f;
#pragma unroll
                for (int bj = 0; bj < 2; ++bj)
#pragma unroll
                    for (int n = 0; n < 2; ++n) { const f32x4 x = v[ai][bj][m][n]; q += (x[0] * x[0] + x[1] * x[1]) + (x[2] * x[2] + x[3] * x[3]); }
                q = xsum32(xsum16(q));
                if (fq == 0) P[(ai * HALF + wr * 64 + m * 16 + fr) * 4 + wc] = q;
            }
        asm volatile("s_waitcnt lgkmcnt(0)" ::: "memory"); __builtin_amdgcn_s_barrier(); asm volatile("" ::: "memory");
        const int row = wid * 32 + (lane & 31);
        if (lane < 32) {
            const float t = (P[row * 4 + 0] + P[row * 4 + 1]) + (P[row * 4 + 2] + P[row * 4 + 3]);
            __hip_atomic_store(xbuf + ((size_t)(u.pm * BM + row) * 4 + u.pn), __float_as_uint(t), __ATOMIC_RELAXED, __HIP_MEMORY_SCOPE_AGENT);
        }
        asm volatile("s_waitcnt vmcnt(0)" ::: "memory");
        if (lane == 0) __hip_atomic_fetch_add(cnt + 64 * u.pm, 1u, __ATOMIC_RELAXED, __HIP_MEMORY_SCOPE_AGENT);
        if (wid == 0) {
            unsigned sp = 0u;
            for (;;) {
                if ((unsigned)__builtin_amdgcn_readfirstlane(__hip_atomic_load(cnt + 64 * u.pm, __ATOMIC_RELAXED, __HIP_MEMORY_SCOPE_AGENT)) >= 32u) break;
                if (++sp > (1u << 20)) { if (lane == 0) __hip_atomic_store(tmo, 1u, __ATOMIC_RELAXED, __HIP_MEMORY_SCOPE_AGENT); break; }
                __builtin_amdgcn_s_sleep(2);
            }
            __builtin_amdgcn_fence(__ATOMIC_ACQUIRE, "agent");
        }
        asm volatile("s_waitcnt vmcnt(0) lgkmcnt(0)" ::: "memory"); __builtin_amdgcn_s_barrier(); asm volatile("" ::: "memory");
        if (lane < 32) {
            const unsigned* slot = xbuf + (size_t)(u.pm * BM + row) * 4; float t = 0.f;
#pragma unroll
            for (int p = 0; p < 4; ++p) t += __uint_as_float(__hip_atomic_load(slot + p, __ATOMIC_RELAXED, __HIP_MEMORY_SCOPE_AGENT));
            S[row] = 1.0f / sqrtf(t * (1.f / 1024.f) + 1e-6f);
        }
        asm volatile("s_waitcnt lgkmcnt(0)" ::: "memory"); __builtin_amdgcn_s_barrier(); asm volatile("" ::: "memory");
    }
};
template <bool HAS_H> struct EpiRmsRes {
    static constexpr bool PERM = false, AFTER_DRAIN = true;
    const float* base; float* out; bf16_t* hb; const float* gpost; const float* gpre; float wgt; RmsExchange st1, st2;
    __device__ __forceinline__ void operator()(const f32x4 (&)[2][2][4][2], const Unit&, int, int, int, int) const {}
    __device__ __forceinline__ void fused(f32x4 (&acc)[2][2][4][2], const Unit& u, int wr, int wc, int fr, int fq, LAS unsigned char* lds, int wid, int lane) const {
        const LAS float* S = (const LAS float*)(lds + 8192);
        const int col0 = u.pn * BM + wc * 32 + 4 * fq;
        f32x4 pre[4][2][2];
#pragma unroll
        for (int m = 0; m < 4; ++m) { const size_t off = (size_t)(u.pm * BM + wr * 64 + m * 16 + fr) * 1024 + col0;
#pragma unroll
            for (int bj = 0; bj < 2; ++bj)
#pragma unroll
                for (int n = 0; n < 2; ++n) pre[m][bj][n] = __builtin_nontemporal_load((const f32x4*)(base + off + bj * HALF + n * 16)); }
        st1.run(acc, u, wr, wc, fr, fq, lds, wid, lane);
        {
            f32x4 gp[2][2];
#pragma unroll
            for (int bj = 0; bj < 2; ++bj)
#pragma unroll
                for (int n = 0; n < 2; ++n) gp[bj][n] = *(const f32x4*)(gpost + col0 + bj * HALF + n * 16);
#pragma unroll
            for (int ai = 0; ai < 2; ++ai)
#pragma unroll
                for (int m = 0; m < 4; ++m) { const int r = ai * HALF + wr * 64 + m * 16 + fr; const float rs = S[r] * wgt;
#pragma unroll
                    for (int bj = 0; bj < 2; ++bj)
#pragma unroll
                        for (int n = 0; n < 2; ++n) acc[ai][bj][m][n] = pre[m][bj][n] + acc[ai][bj][m][n] * rs * gp[bj][n];
                    asm volatile("" : "+v"(acc[ai][0][m][0]), "+v"(acc[ai][0][m][1]), "+v"(acc[ai][1][m][0]), "+v"(acc[ai][1][m][1]));
                    if (ai == 0) {
                        const size_t off2 = (size_t)(u.pm * BM + HALF + wr * 64 + m * 16 + fr) * 1024 + col0;
#pragma unroll
                        for (int bj = 0; bj < 2; ++bj)
#pragma unroll
                            for (int n = 0; n < 2; ++n) pre[m][bj][n] = __builtin_nontemporal_load((const f32x4*)(base + off2 + bj * HALF + n * 16));
                    }
                }
        }
        if (HAS_H) st2.run(acc, u, wr, wc, fr, fq, lds, wid, lane);
        f32x4 gq[2][2];
        if (HAS_H) {
#pragma unroll
            for (int bj = 0; bj < 2; ++bj)
#pragma unroll
                for (int n = 0; n < 2; ++n) gq[bj][n] = *(const f32x4*)(gpre + col0 + bj * HALF + n * 16);
        }
#pragma unroll
        for (int ai = 0; ai < 2; ++ai)
#pragma unroll
            for (int m = 0; m < 4; ++m) { const int r = ai * HALF + wr * 64 + m * 16 + fr; const float rs2 = HAS_H ? S[r] : 0.f; const size_t off = (size_t)(u.pm * BM + r) * 1024 + col0;
#pragma unroll
                for (int bj = 0; bj < 2; ++bj) {
#pragma unroll
                    for (int n = 0; n < 2; ++n) *(f32x4*)(out + off + bj * HALF + n * 16) = acc[ai][bj][m][n];
                    if (HAS_H) {
                        const f32x4 oa = acc[ai][bj][m][0] * rs2 * gq[bj][0], ob = acc[ai][bj][m][1] * rs2 * gq[bj][1];
                        const unsigned ax = cvt_pk_bf16(oa[0], oa[1]), ay = cvt_pk_bf16(oa[2], oa[3]), bx_ = cvt_pk_bf16(ob[0], ob[1]), by_ = cvt_pk_bf16(ob[2], ob[3]);
                        const auto sx = __builtin_amdgcn_permlane16_swap(ax, bx_, false, false), sy = __builtin_amdgcn_permlane16_swap(ay, by_, false, false);
                        u32x4 w; w.x = sx[0]; w.y = sy[0]; w.z = sx[1]; w.w = sy[1];
                        *(u32x4*)(hb + (size_t)(u.pm * BM + r) * 1024 + u.pn * BM + wc * 32 + bj * HALF + 16 * (fq & 1) + 8 * (fq >> 1)) = w; }
                }
                asm volatile("" ::: "memory"); }
    }
};
}

__device__ __forceinline__ void transpose_item(const float* W, int K, int N, bf16_t* WT, int mode, int row_off, LAS float* scr, int item, int lane) {
    const int nblk = N / 32, kb = item / nblk, nb = item % nblk, k0 = 64 * kb, n0 = 32 * nb;
    { f32x4 v[8];
#pragma unroll
        for (int i = 0; i < 8; ++i) v[i] = __builtin_nontemporal_load((const f32x4*)(W + (size_t)(k0 + 8 * i + (lane >> 3)) * N + n0 + 4 * (lane & 7)));
#pragma unroll
        for (int i = 0; i < 8; ++i) { LAS float* d = scr + (8 * i + (lane >> 3)) * 33 + 4 * (lane & 7); d[0] = v[i].x; d[1] = v[i].y; d[2] = v[i].z; d[3] = v[i].w; } }
    asm volatile("s_waitcnt lgkmcnt(0)" ::: "memory");
    const int c = lane & 7;
    const int drow0 = (mode == 0) ? (row_off + n0) : ((n0 >> 7) * 256 + row_off + (n0 & 127));
#pragma unroll
    for (int j = 0; j < 4; ++j) { const int n = (lane >> 3) + 8 * j; const LAS float* s = scr + (8 * c) * 33 + n;
        u32x4 o; o.x = cvt_pk_bf16(s[0 * 33], s[1 * 33]); o.y = cvt_pk_bf16(s[2 * 33], s[3 * 33]); o.z = cvt_pk_bf16(s[4 * 33], s[5 * 33]); o.w = cvt_pk_bf16(s[6 * 33], s[7 * 33]);
        *(u32x4*)(WT + (size_t)(drow0 + n) * K + k0 + 8 * c) = o; }
    asm volatile("s_waitcnt lgkmcnt(0)" ::: "memory");
}

__device__ __forceinline__ void rms_row_to_bf16(const float* xrow, const float* g, bf16_t* orow, int lane) {
    const f32x4* xr = (const f32x4*)xrow + lane; const f32x4* gr = (const f32x4*)g + lane;
    f32x4 v[4]; float s = 0.f;
#pragma unroll
    for (int j = 0; j < 4; ++j) { v[j] = __builtin_nontemporal_load(xr + 64 * j); s += (v[j].x * v[j].x + v[j].y * v[j].y) + (v[j].z * v[j].z + v[j].w * v[j].w); }
    const float rs = 1.0f / sqrtf(wave_sum(s) * (1.f / 1024.f) + EPS);
    u32x2* o8 = (u32x2*)orow + lane;
#pragma unroll
    for (int j = 0; j < 4; ++j) { const f32x4 gg = gr[64 * j]; u32x2 w; w.x = cvt_pk_bf16(v[j].x * rs * gg.x, v[j].y * rs * gg.y); w.y = cvt_pk_bf16(v[j].z * rs * gg.z, v[j].w * rs * gg.w); o8[64 * j] = w; }
}
__device__ __forceinline__ void rms_row4_to_bf16(const float* x0, size_t rstride, const float* g, bf16_t* o0, int lane) {
    const f32x4* gr = (const f32x4*)g + lane;
    f32x4 v[4][4]; float sq[4];
#pragma unroll
    for (int r = 0; r < 4; ++r)
#pragma unroll
        for (int j = 0; j < 4; ++j) v[r][j] = __builtin_nontemporal_load((const f32x4*)(x0 + r * rstride) + lane + 64 * j);
#pragma unroll
    for (int r = 0; r < 4; ++r) { float a = 0.f;
#pragma unroll
        for (int j = 0; j < 4; ++j) a += (v[r][j].x * v[r][j].x + v[r][j].y * v[r][j].y) + (v[r][j].z * v[r][j].z + v[r][j].w * v[r][j].w);
        sq[r] = 1.0f / sqrtf(wave_sum(a) * (1.f / 1024.f) + EPS); }
#pragma unroll
    for (int j = 0; j < 4; ++j) { const f32x4 gg = gr[64 * j];
#pragma unroll
        for (int r = 0; r < 4; ++r) { u32x2 w; w.x = cvt_pk_bf16(v[r][j].x * sq[r] * gg.x, v[r][j].y * sq[r] * gg.y); w.y = cvt_pk_bf16(v[r][j].z * sq[r] * gg.z, v[r][j].w * sq[r] * gg.w);
            ((u32x2*)(o0 + r * rstride) + lane)[64 * j] = w; } }
}
__device__ __forceinline__ void rms_row2_to_bf16(const float* xrow0, const float* xrow1, const float* g, bf16_t* orow0, bf16_t* orow1, int lane) {
    const f32x4* xa = (const f32x4*)xrow0 + lane; const f32x4* xb = (const f32x4*)xrow1 + lane; const f32x4* gr = (const f32x4*)g + lane;
    f32x4 va[4], vb[4], gg[4]; float sa = 0.f, sb = 0.f;
#pragma unroll
    for (int j = 0; j < 4; ++j) { va[j] = __builtin_nontemporal_load(xa + 64 * j); vb[j] = __builtin_nontemporal_load(xb + 64 * j); gg[j] = gr[64 * j]; }
#pragma unroll
    for (int j = 0; j < 4; ++j) { sa += (va[j].x * va[j].x + va[j].y * va[j].y) + (va[j].z * va[j].z + va[j].w * va[j].w); sb += (vb[j].x * vb[j].x + vb[j].y * vb[j].y) + (vb[j].z * vb[j].z + vb[j].w * vb[j].w); }
    const float ra = 1.0f / sqrtf(wave_sum(sa) * (1.f / 1024.f) + EPS), rb = 1.0f / sqrtf(wave_sum(sb) * (1.f / 1024.f) + EPS);
    u32x2* oa = (u32x2*)orow0 + lane; u32x2* ob = (u32x2*)orow1 + lane;
#pragma unroll
    for (int j = 0; j < 4; ++j) { u32x2 w; w.x = cvt_pk_bf16(va[j].x * ra * gg[j].x, va[j].y * ra * gg[j].y); w.y = cvt_pk_bf16(va[j].z * ra * gg[j].z, va[j].w * ra * gg[j].w); oa[64 * j] = w;
        u32x2 v; v.x = cvt_pk_bf16(vb[j].x * rb * gg[j].x, vb[j].y * rb * gg[j].y); v.y = cvt_pk_bf16(vb[j].z * rb * gg[j].z, vb[j].w * rb * gg[j].w); ob[64 * j] = v; }
}
template <int NMAPS, int DK, int DV, bool CAUSAL, bool STORE = true, bool ALIBI = CAUSAL>
__device__ __forceinline__ void attn_unit(LAS unsigned char* lds, const bf16_t* Qg, const bf16_t* Kg, int kpitch, const bf16_t* Vg, int vpitch, bf16_t* Og, int qpitch,
                                          int q0, int ntiles, float c1, float slope2, float lam, const float* head_g) {
    constexpr int KW = NMAPS * DK, KP = KW + 8, VP = DV + 16;
    constexpr int KCH = KW / 8, VCH = DV / 8, KLD = 64 * KCH / 512, VLD = 64 * VCH / 512;
    constexpr int NKS = DK / 32, NDT = DV / 16;
    constexpr int TILEB = 64 * KP * 2 + 64 * VP * 2;
    constexpr bool LATEW = (NMAPS == 1);
    static_assert(!LATEW || !CAUSAL, "late-write form has no skipped tiles");
    int tid = threadIdx.x; asm volatile("" : "+v"(tid));
    const int lane = tid & 63, wid = __builtin_amdgcn_readfirstlane(tid >> 6), qi = lane & 15, g = lane >> 4;
    bf16x8 qf[NMAPS][NKS];
    { const bf16_t* qrow = Qg + (size_t)(wid * 16 + qi) * qpitch;
#pragma unroll
      for (int m = 0; m < NMAPS; ++m)
#pragma unroll
          for (int ks = 0; ks < NKS; ++ks) qf[m][ks] = *(const bf16x8*)(qrow + m * DK + ks * 32 + g * 8); }
    f32x4 O[NMAPS][NDT]; float mrun[NMAPS], lrun[NMAPS];
#pragma unroll
    for (int m = 0; m < NMAPS; ++m) { mrun[m] = -INFINITY; lrun[m] = 0.f;
#pragma unroll
        for (int dt = 0; dt < NDT; ++dt) O[m][dt] = (f32x4){0.f, 0.f, 0.f, 0.f}; }
    u32x4 kreg[KLD], vreg[VLD];
#define ATT_LOADREGS(t) do { \
    _Pragma("unroll") for (int c_ = 0; c_ < KLD; ++c_) { const int idx_ = tid + c_ * 512, row_ = idx_ / KCH, ch_ = idx_ % KCH; kreg[c_] = *(const u32x4*)(Kg + (size_t)((t) * 64 + row_) * kpitch + ch_ * 8); } \
    _Pragma("unroll") for (int c_ = 0; c_ < VLD; ++c_) { const int idx_ = tid + c_ * 512, row_ = idx_ / VCH, ch_ = idx_ % VCH; vreg[c_] = *(const u32x4*)(Vg + (size_t)((t) * 64 + row_) * vpitch + ch_ * 8); } } while (0)
#define ATT_WRITELDS(Kw, Vw) do { \
    _Pragma("unroll") for (int c_ = 0; c_ < KLD; ++c_) { const int idx_ = tid + c_ * 512, row_ = idx_ / KCH, ch_ = idx_ % KCH; *(LAS u32x4*)(Kw + (row_ * KP + ch_ * 8) * 2) = kreg[c_]; } \
    _Pragma("unroll") for (int c_ = 0; c_ < VLD; ++c_) { const int idx_ = tid + c_ * 512, row_ = idx_ / VCH, ch_ = idx_ % VCH; *(LAS u32x4*)(Vw + (row_ * VP + ch_ * 8) * 2) = vreg[c_]; } } while (0)
#define ATT_TILE(i_) (CAUSAL ? (ntiles - 1 - (i_)) : (i_))
    __syncthreads();
    ATT_LOADREGS(ATT_TILE(0));
    ATT_WRITELDS(lds, lds + 64 * KP * 2);
    if (!LATEW && ntiles > 1) ATT_LOADREGS(ATT_TILE(1));
    __syncthreads();
    const int qpos = q0 + wid * 16 + qi;
    const int q4 = qi >> 2, p4 = qi & 3;
    f32x4 kbv[4];
#pragma unroll
    for (int tt = 0; tt < 4; ++tt)
#pragma unroll
        for (int r = 0; r < 4; ++r) kbv[tt][r] = ALIBI ? slope2 * (float)(16 * tt + 4 * g + r) : 0.f;
    for (int ti = 0; ti < ntiles; ++ti) {
        const int t = ATT_TILE(ti);
        LAS unsigned char* Kl = lds + (ti & 1) * TILEB; LAS unsigned char* Vl = Kl + 64 * KP * 2;
        if (!LATEW) {
            if (ti + 1 < ntiles) { LAS unsigned char* Kn = lds + ((ti + 1) & 1) * TILEB; ATT_WRITELDS(Kn, Kn + 64 * KP * 2); }
            if (ti + 2 < ntiles) ATT_LOADREGS(ATT_TILE(ti + 2));
        } else if (ti + 1 < ntiles) ATT_LOADREGS(ATT_TILE(ti + 1));
        const int k0 = 64 * t;
        const bool skip = CAUSAL && (k0 > q0 + wid * 16 + 15);
        if (!skip) {
            f32x4 s[NMAPS][4];
#pragma unroll
            for (int m = 0; m < NMAPS; ++m)
#pragma unroll
                for (int tt = 0; tt < 4; ++tt) { f32x4 a = (f32x4){0.f, 0.f, 0.f, 0.f};
#pragma unroll
                    for (int ks = 0; ks < NKS; ++ks) { const bf16x8 kf = *(const LAS bf16x8*)(Kl + ((16 * tt + qi) * KP + m * DK + ks * 32 + g * 8) * 2);
                        a = __builtin_amdgcn_mfma_f32_16x16x32_bf16(kf, qf[m][ks], a, 0, 0, 0); }
                    s[m][tt] = a; if (NKS > 2) __builtin_amdgcn_sched_barrier(0); }
            const bool needmask = CAUSAL && (k0 + 63 > q0 + wid * 16);
            const float tb = ALIBI ? slope2 * (float)k0 : 0.f;
            float mxv[NMAPS];
#pragma unroll
            for (int m = 0; m < NMAPS; ++m) {
#pragma unroll
                for (int tt = 0; tt < 4; ++tt) { s[m][tt] = ALIBI ? (s[m][tt] * c1 + kbv[tt]) : (s[m][tt] * c1);
                    if (needmask) {
#pragma unroll
                        for (int r = 0; r < 4; ++r) { const int kpos = k0 + 16 * tt + 4 * g + r; if (kpos > qpos) s[m][tt][r] = -INFINITY; } } }
                float mx = fmaxf(fmaxf(s[m][0][0], s[m][0][1]), s[m][0][2]);
                mx = fmaxf(fmaxf(mx, s[m][0][3]), s[m][1][0]); mx = fmaxf(fmaxf(mx, s[m][1][1]), s[m][1][2]); mx = fmaxf(fmaxf(mx, s[m][1][3]), s[m][2][0]);
                mx = fmaxf(fmaxf(mx, s[m][2][1]), s[m][2][2]); mx = fmaxf(fmaxf(mx, s[m][2][3]), s[m][3][0]); mx = fmaxf(fmaxf(mx, s[m][3][1]), s[m][3][2]); mx = fmaxf(mx, s[m][3][3]);
                mxv[m] = xmax32(xmax16(mx)) + tb;
            }
            bool dead = ALIBI;
#pragma unroll
            for (int m = 0; m < NMAPS; ++m) dead = dead && (mxv[m] - mrun[m] < -126.f);
            if (!(ALIBI && __all(dead))) {
#pragma unroll
            for (int m = 0; m < NMAPS; ++m) {
                const float mcand = fmaxf(mrun[m], mxv[m]);
                const float mnew = (mcand - mrun[m] > 8.f) ? mcand : mrun[m];
                const float alpha = fast_exp2(mrun[m] - mnew); mrun[m] = mnew;
                const float sub = mnew - tb;
                f32x4 ps4 = (f32x4){0.f, 0.f, 0.f, 0.f}; const f32x4 nsub4 = (f32x4){-sub, -sub, -sub, -sub};
#pragma unroll
                for (int tt = 0; tt < 4; ++tt) { const f32x4 d = s[m][tt] + nsub4; f32x4 p; p[0] = fast_exp2(d[0]); p[1] = fast_exp2(d[1]); p[2] = fast_exp2(d[2]); p[3] = fast_exp2(d[3]); s[m][tt] = p; ps4 = ps4 + p; }
                lrun[m] = lrun[m] * alpha + ((ps4[0] + ps4[1]) + (ps4[2] + ps4[3]));
                if (__any(alpha != 1.f)) {
#pragma unroll
                    for (int dt = 0; dt < NDT; ++dt) O[m][dt] = O[m][dt] * alpha;
                }
            }
            if (LATEW && ti + 1 < ntiles) { LAS unsigned char* Kn = lds + ((ti + 1) & 1) * TILEB; ATT_WRITELDS(Kn, Kn + 64 * KP * 2); }
#pragma unroll
            for (int kk = 0; kk < 2; ++kk) {
                bf16x8 pf[NMAPS];
#pragma unroll
                for (int m = 0; m < NMAPS; ++m) { u32x4 w; w.x = cvt_pk_bf16(s[m][2 * kk][0], s[m][2 * kk][1]); w.y = cvt_pk_bf16(s[m][2 * kk][2], s[m][2 * kk][3]);
                    w.z = cvt_pk_bf16(s[m][2 * kk + 1][0], s[m][2 * kk + 1][1]); w.w = cvt_pk_bf16(s[m][2 * kk + 1][2], s[m][2 * kk + 1][3]); pf[m] = __builtin_bit_cast(bf16x8, w); }
#pragma unroll
                for (int dt = 0; dt < NDT; ++dt) {
                    LAS unsigned char* vp = Vl + ((32 * kk + 4 * g + q4) * VP + 16 * dt + 4 * p4) * 2;
                    const s16x4 lo = __builtin_bit_cast(s16x4, __builtin_amdgcn_ds_read_tr16_b64_v4i16((LAS s16x4*)vp));
                    const s16x4 hi = __builtin_bit_cast(s16x4, __builtin_amdgcn_ds_read_tr16_b64_v4i16((LAS s16x4*)(vp + 16 * VP * 2)));
                    const bf16x8 vf = (bf16x8){lo[0], lo[1], lo[2], lo[3], hi[0], hi[1], hi[2], hi[3]};
#pragma unroll
                    for (int m = 0; m < NMAPS; ++m) O[m][dt] = __builtin_amdgcn_mfma_f32_16x16x32_bf16(vf, pf[m], O[m][dt], 0, 0, 0);
                    if (NDT > 8 && (dt & 3) == 3) __builtin_amdgcn_sched_barrier(0);
                }
            }
            }
        }
        __syncthreads();
    }
#undef ATT_TILE
#undef ATT_LOADREGS
#undef ATT_WRITELDS
    float inv[NMAPS];
#pragma unroll
    for (int m = 0; m < NMAPS; ++m) { const float l = xsum32(xsum16(lrun[m])); inv[m] = 1.0f / l; }
    bf16_t* orow = Og + (size_t)(wid * 16 + qi) * qpitch + 4 * g;
    if (NMAPS == 2) {
        float ss = 0.f;
#pragma unroll
        for (int dt = 0; dt < NDT; ++dt)
#pragma unroll
            for (int r = 0; r < 4; ++r) { const float o = O[0][dt][r] * inv[0] - lam * (O[NMAPS - 1][dt][r] * inv[NMAPS - 1]); O[0][dt][r] = o; ss += o * o; }
        ss = xsum32(xsum16(ss));
        const float rn = 0.8f / sqrtf(ss * (1.f / (float)DV) + EPS);
        bf16_t* orow16 = Og + (size_t)(wid * 16 + qi) * qpitch + 16 * (g & 1) + 8 * (g >> 1);
#pragma unroll
        for (int dp = 0; dp < NDT; dp += 2) { const f32x4 ga = *(const f32x4*)(head_g + 16 * dp + 4 * g), gb = *(const f32x4*)(head_g + 16 * dp + 16 + 4 * g);
            const unsigned ax = cvt_pk_bf16(O[0][dp][0] * rn * ga.x, O[0][dp][1] * rn * ga.y), ay = cvt_pk_bf16(O[0][dp][2] * rn * ga.z, O[0][dp][3] * rn * ga.w);
            const unsigned bx = cvt_pk_bf16(O[0][dp + 1][0] * rn * gb.x, O[0][dp + 1][1] * rn * gb.y), by = cvt_pk_bf16(O[0][dp + 1][2] * rn * gb.z, O[0][dp + 1][3] * rn * gb.w);
            const auto sx = __builtin_amdgcn_permlane16_swap(ax, bx, false, false), sy = __builtin_amdgcn_permlane16_swap(ay, by, false, false);
            u32x4 w; w.x = sx[0]; w.y = sy[0]; w.z = sx[1]; w.w = sy[1];
            if (STORE) *(u32x4*)(orow16 + 16 * dp) = w; else asm volatile("" :: "v"(w.x), "v"(w.y), "v"(w.z), "v"(w.w)); }
    } else {
        bf16_t* orow16 = Og + (size_t)(wid * 16 + qi) * qpitch + 16 * (g & 1) + 8 * (g >> 1);
#pragma unroll
        for (int dp = 0; dp < NDT; dp += 2) {
            const unsigned ax = cvt_pk_bf16(O[0][dp][0] * inv[0], O[0][dp][1] * inv[0]), ay = cvt_pk_bf16(O[0][dp][2] * inv[0], O[0][dp][3] * inv[0]);
            const unsigned bx = cvt_pk_bf16(O[0][dp + 1][0] * inv[0], O[0][dp + 1][1] * inv[0]), by = cvt_pk_bf16(O[0][dp + 1][2] * inv[0], O[0][dp + 1][3] * inv[0]);
            const auto sx = __builtin_amdgcn_permlane16_swap(ax, bx, false, false), sy = __builtin_amdgcn_permlane16_swap(ay, by, false, false);
            u32x4 w; w.x = sx[0]; w.y = sy[0]; w.z = sx[1]; w.w = sy[1];
            if (STORE) *(u32x4*)(orow16 + 16 * dp) = w; else asm volatile("" :: "v"(w.x), "v"(w.y), "v"(w.z), "v"(w.w)); }
    }
}

__device__ __forceinline__ float gelu_tanh(float y) {
    const float z = 0.7978845608028654f * (y + 0.044715f * y * y * y);
    const float e = fast_exp2(2.f * z * LOG2E);
    const float th = 1.f - 2.f * fast_rcp(e + 1.f);
    return 0.5f * y * (1.f + th);
}
template <bool STORE>
__device__ __forceinline__ void lru_unit(LAS unsigned char* lds, int b, int n, const bf16_t* X, bf16_t* Y, const bf16_t* WT,
                                         const float* conv_w, const float* conv_b, const float* b_a, const float* b_x, const float* lam) {
    constexpr int XP = 136;
    LAS bf16_t* Xl = (LAS bf16_t*)lds; LAS bf16_t* Yl = Xl + 128 * XP;
    int tid = threadIdx.x; asm volatile("" : "+v"(tid));
    const int lane = tid & 63, wid = __builtin_amdgcn_readfirstlane(tid >> 6), li = lane & 15, g = lane >> 4;
    const int ch = tid & 15, rbase = tid >> 4;
    const float* cwl = conv_w + 128 * n + 8 * ch; const float* cbl = conv_b + 128 * n + 8 * ch;
    const int cl = 16 * wid + li, cg_ = 128 * n + cl;
    const float ba = b_a[cg_], bx = b_x[cg_];
    const float sp8l2 = 8.f * log1pf(expf(-lam[cg_])) * LOG2E;
    bf16x8 wa[4], wx[4];
#pragma unroll
    for (int ks = 0; ks < 4; ++ks) { wa[ks] = *(const bf16x8*)(WT + ((size_t)(0 * 8 + n) * 128 + cl) * 128 + 32 * ks + 8 * g);
                                     wx[ks] = *(const bf16x8*)(WT + ((size_t)(1 * 8 + n) * 128 + cl) * 128 + 32 * ks + 8 * g); }
    float hc = 0.f;
    LAS bf16_t* Xr = Yl + 128 * XP;
    u32x4 xr[5], yr[4];
#define LRU_LOAD(c_) do { \
    _Pragma("unroll") for (int k_ = 0; k_ < 5; ++k_) { const int id_ = tid + 512 * k_, row_ = id_ >> 4, chx_ = id_ & 15; const int trel_ = 128 * (c_) - 3 + row_; \
        xr[k_] = (id_ < 131 * 16 && trel_ >= 0) ? *(const u32x4*)(X + ((size_t)b * SEQ + trel_) * 1024 + 128 * n + 8 * chx_) : (u32x4){0u, 0u, 0u, 0u}; } \
    _Pragma("unroll") for (int p_ = 0; p_ < 4; ++p_) yr[p_] = *(const u32x4*)(Y + ((size_t)b * SEQ + 128 * (c_) + rbase + 32 * p_) * 1024 + 128 * n + 8 * ch); } while (0)
    LRU_LOAD(0);
    for (int chunk = 0; chunk < 16; ++chunk) {
        const size_t tok0 = (size_t)b * SEQ + 128 * chunk;
        __syncthreads();
#pragma unroll
        for (int k = 0; k < 5; ++k) { const int id = tid + 512 * k, row = id >> 4, chx = id & 15; if (id < 131 * 16) *(LAS u32x4*)(Xr + row * XP + 8 * chx) = xr[k]; }
#pragma unroll
        for (int p = 0; p < 4; ++p) *(LAS u32x4*)(Yl + (rbase + 32 * p) * XP + 8 * ch) = yr[p];
        __syncthreads();
        if (chunk + 1 < 16) LRU_LOAD(chunk + 1);
        float cw[4][8], cb[8];
        { const float* cwp = cwl; const float* cbp = cbl; asm volatile("" : "+v"(cwp), "+v"(cbp));
          const f32x4 b0 = *(const f32x4*)cbp, b1 = *(const f32x4*)(cbp + 4); cb[0] = b0.x; cb[1] = b0.y; cb[2] = b0.z; cb[3] = b0.w; cb[4] = b1.x; cb[5] = b1.y; cb[6] = b1.z; cb[7] = b1.w;
#pragma unroll
          for (int j = 0; j < 4; ++j) { const f32x4 w0 = *(const f32x4*)(cwp + j * 1024), w1 = *(const f32x4*)(cwp + j * 1024 + 4);
              cw[j][0] = w0.x; cw[j][1] = w0.y; cw[j][2] = w0.z; cw[j][3] = w0.w; cw[j][4] = w1.x; cw[j][5] = w1.y; cw[j][6] = w1.z; cw[j][7] = w1.w; } }
#pragma unroll
        for (int p = 0; p < 4; ++p) {
            const int row = rbase + 32 * p;
            float a[8];
#pragma unroll
            for (int e = 0; e < 8; ++e) a[e] = cb[e];
#pragma unroll
            for (int j = 0; j < 4; ++j) { const u32x4 v = *(const LAS u32x4*)(Xr + (row + j) * XP + 8 * ch);
                a[0] += cw[j][0] * bf_lo(v.x); a[1] += cw[j][1] * bf_hi(v.x); a[2] += cw[j][2] * bf_lo(v.y); a[3] += cw[j][3] * bf_hi(v.y);
                a[4] += cw[j][4] * bf_lo(v.z); a[5] += cw[j][5] * bf_hi(v.z); a[6] += cw[j][6] * bf_lo(v.w); a[7] += cw[j][7] * bf_hi(v.w); }
            u32x4 w; w.x = cvt_pk_bf16(a[0], a[1]); w.y = cvt_pk_bf16(a[2], a[3]); w.z = cvt_pk_bf16(a[4], a[5]); w.w = cvt_pk_bf16(a[6], a[7]);
            *(LAS u32x4*)(Xl + row * XP + 8 * ch) = w;
        }
        __syncthreads();
        {
            float pa[8][4], pb[8][4];
#pragma unroll
            for (int tt = 0; tt < 8; ++tt) {
                f32x4 da = (f32x4){0.f, 0.f, 0.f, 0.f}, dx = (f32x4){0.f, 0.f, 0.f, 0.f};
#pragma unroll
                for (int ks = 0; ks < 4; ++ks) { const bf16x8 af = *(const LAS bf16x8*)(Xl + (16 * tt + li) * XP + 32 * ks + 8 * g);
                    da = __builtin_amdgcn_mfma_f32_16x16x32_bf16(af, wa[ks], da, 0, 0, 0); dx = __builtin_amdgcn_mfma_f32_16x16x32_bf16(af, wx[ks], dx, 0, 0, 0); }
#pragma unroll
                for (int r = 0; r < 4; ++r) { const int tl = 16 * tt + 4 * g + r; const float xcv = bf2f(Xl[tl * XP + cl]);
                    const float rr = sigmoidf_(da[r] + ba), ii = sigmoidf_(dx[r] + bx);
                    const float a = fast_exp2(-sp8l2 * rr); const float u = __builtin_amdgcn_sqrtf(fmaxf(__builtin_fmaf(-a, a, 1.f), 0.f)) * (ii * xcv);
                    if (r == 0) { pa[tt][0] = a; pb[tt][0] = u; } else { pa[tt][r] = a * pa[tt][r - 1]; pb[tt][r] = a * pb[tt][r - 1] + u; } }
            }
            float ea[8], eb[8], Ta[8], Tb[8];
#pragma unroll
            for (int tt = 0; tt < 8; ++tt) {
                float sa = pa[tt][3], sb = pb[tt][3];
                { const float ta = __shfl_up(sa, 16), tb = __shfl_up(sb, 16); if (g >= 1) { sb = sa * tb + sb; sa = ta * sa; } }
                { const float ta = __shfl_up(sa, 32), tb = __shfl_up(sb, 32); if (g >= 2) { sb = sa * tb + sb; sa = ta * sa; } }
                float e0 = __shfl_up(sa, 16), e1 = __shfl_up(sb, 16); if (g == 0) { e0 = 1.f; e1 = 0.f; }
                ea[tt] = e0; eb[tt] = e1; Ta[tt] = __shfl(sa, 48 + li); Tb[tt] = __shfl(sb, 48 + li);
            }
#pragma unroll
            for (int tt = 0; tt < 8; ++tt) {
                const float hg = ea[tt] * hc + eb[tt];
                hc = Ta[tt] * hc + Tb[tt];
#pragma unroll
                for (int r = 0; r < 4; ++r) { const int tl = 16 * tt + 4 * g + r; const float h = pa[tt][r] * hg + pb[tt][r];
                    const float yv = bf2f(Yl[tl * XP + cl]); Yl[tl * XP + cl] = f2bf(h * gelu_tanh(yv)); }
            }
        }
        __syncthreads();
#pragma unroll
        for (int p = 0; p < 4; ++p) { const int row = rbase + 32 * p; const u32x4 ov = *(const LAS u32x4*)(Yl + row * XP + 8 * ch); if (STORE) *(u32x4*)(Y + (tok0 + row) * 1024 + 128 * n + 8 * ch) = ov; else asm volatile("" :: "v"(ov.x), "v"(ov.y), "v"(ov.z), "v"(ov.w)); }
    }
}


#define XB_TMO      128
#define XB_XCNT(j)  (256  + 64 * (j))
#define XB_XSUB(j)  (1280 + 64 * (j))
#define XB_XGEN(j)  (2304 + 64 * (j))
#define XB_TOP      3328
#define XB_TOPGEN   3392
#define XCD_BAR_WORDS 3456
#define XB_SPIN_CAP (1u << 18)
__device__ __forceinline__ unsigned xb_ld(unsigned* p)              { return __hip_atomic_load(p, __ATOMIC_RELAXED, __HIP_MEMORY_SCOPE_AGENT); }
__device__ __forceinline__ unsigned xb_add(unsigned* p, unsigned v) { return __hip_atomic_fetch_add(p, v, __ATOMIC_RELAXED, __HIP_MEMORY_SCOPE_AGENT); }
__device__ __forceinline__ unsigned xb_xcc_id() { return (unsigned)__builtin_amdgcn_s_getreg((3 << 11) | 20) & 0xFu; }
#define XB_SPIN(cond, bar) do { unsigned _sp = 0; while (cond) { __builtin_amdgcn_s_sleep(1); \
    if ((++_sp & 255u) == 0u) { if (xb_ld(&(bar)[XB_TMO])) break; if (_sp > XB_SPIN_CAP) { atomicAdd(&(bar)[XB_TMO], 1u); break; } } } } while (0)
struct XcdBarrier { unsigned* bar; unsigned x; volatile LAS unsigned* st; };
__device__ __forceinline__ XcdBarrier xcd_barrier_post(unsigned* bar, volatile LAS unsigned* st) {
    XcdBarrier b; b.bar = bar; b.x = xb_xcc_id(); b.st = st;
    if (threadIdx.x == 0) (void)xb_add(&bar[XB_XCNT(b.x)], 1u);
    return b;
}
__device__ __forceinline__ void xcd_barrier_complete(unsigned* bar, unsigned x, unsigned& nloc, unsigned& nx) {
    const unsigned G = gridDim.x * gridDim.y * gridDim.z;
    unsigned sum, cnt, mine, sp = 0u;
    for (;;) {
        sum = 0u; cnt = 0u; mine = 0u;
#pragma unroll
        for (unsigned j = 0; j < 16; ++j) { const unsigned c = xb_ld(&bar[XB_XCNT(j)]); sum += c; cnt += (c > 0u) ? 1u : 0u; mine = (j == x) ? c : mine; }
        if (sum == G) break;
        __builtin_amdgcn_s_sleep(1);
        if ((++sp & 255u) == 0u) { if (xb_ld(&bar[XB_TMO])) break; if (sp > XB_SPIN_CAP) { atomicAdd(&bar[XB_TMO], 1u); break; } }
    }
    nloc = mine > 0u ? mine : 1u; nx = cnt > 0u ? cnt : 1u;
}
__device__ __forceinline__ void xcd_barrier(const XcdBarrier& b) {
    asm volatile("s_waitcnt vmcnt(0)" ::: "memory");
    __syncthreads();
    if (threadIdx.x == 0) {
        unsigned* bar = b.bar;
        __builtin_amdgcn_s_waitcnt(0);
        unsigned nloc = b.st[0], nx = b.st[1];
        if (nloc == 0u) { xcd_barrier_complete(bar, b.x, nloc, nx); b.st[0] = nloc; b.st[1] = nx; }
        const unsigned old = xb_add(&bar[XB_XSUB(b.x)], 1u);
        const unsigned gen = old / nloc;
        if (old + 1u == (gen + 1u) * nloc) {
            __builtin_amdgcn_fence(__ATOMIC_RELEASE, "agent");
            asm volatile("s_waitcnt vmcnt(0)" ::: "memory");
            const unsigned og = xb_add(&bar[XB_TOP], 1u);
            const unsigned tg = og / nx;
            if (og + 1u == (tg + 1u) * nx) xb_add(&bar[XB_TOPGEN], 1u);
            else XB_SPIN(xb_ld(&bar[XB_TOPGEN]) == tg, bar);
            __builtin_amdgcn_fence(__ATOMIC_ACQUIRE, "agent");
            xb_add(&bar[XB_XGEN(b.x)], 1u);
            asm volatile("s_waitcnt vmcnt(0)" ::: "memory");
        } else {
            XB_SPIN(xb_ld(&bar[XB_XGEN(b.x)]) == gen, bar);
            __builtin_amdgcn_fence(__ATOMIC_ACQUIRE, "agent");
            asm volatile("s_waitcnt vmcnt(0)" ::: "memory");
        }
    }
    __syncthreads();
}
__device__ __forceinline__ const float* ldptr(LAS unsigned long long* PT, int i) { const unsigned long long v = PT[i];
    const unsigned lo = __builtin_amdgcn_readfirstlane((unsigned)v), hi = __builtin_amdgcn_readfirstlane((unsigned)(v >> 32)); return (const float*)(((unsigned long long)hi << 32) | lo); }
constexpr int NWAVES = 8;
constexpr int LDS_BYTES = 147456;
constexpr int MISC_OFF = 143360;
struct Args { const float* in[35]; float* out; unsigned char* ws; };

#define CONV(Wsrc, Kd, Nd, WTdst, mode, roff) { const int ni_ = ((Kd) / 64) * ((Nd) / 32); if (r >= 0) { if (r < ni_) { transpose_item((Wsrc), (Kd), (Nd), (WTdst), (mode), (roff), scr, r, lane); r = -1; } else r -= ni_; } }

__global__ void __launch_bounds__(NWAVES * 64) fwd_megakernel(Args args) {
    extern __shared__ __attribute__((aligned(16))) unsigned char lds_raw[];
    cg::grid_group grid = cg::this_grid();
    LAS unsigned char* lds = (LAS unsigned char*)lds_raw;
    volatile LAS unsigned* MISC = (volatile LAS unsigned*)(lds + MISC_OFF);
    const int wave = __builtin_amdgcn_readfirstlane((int)threadIdx.x >> 6);
    const int G = gridDim.x, bx = blockIdx.x;
    const int gw = bx * NWAVES + wave, NGW = G * NWAVES;
#define CG_SYNC() do { asm volatile("s_waitcnt vmcnt(0) lgkmcnt(0)" ::: "memory"); grid.sync(); \
        if (wave == 0) { __builtin_amdgcn_fence(__ATOMIC_ACQUIRE, "agent"); asm volatile("s_waitcnt vmcnt(0)" ::: "memory"); } __syncthreads(); } while (0)
#define GRID_SYNC() xcd_barrier(xbar)
#define FRESH() int tid = threadIdx.x; asm volatile("" : "+v"(tid)); const int lane = tid & 63; (void)lane
    LAS unsigned long long* PT = (LAS unsigned long long*)(lds + MISC_OFF + 64);
    unsigned* barw = (unsigned*)(args.ws + WS_CTL) + 1024;
    { FRESH();
    if (tid < 35) PT[tid] = (unsigned long long)args.in[tid];
    if (tid < 16) MISC[tid] = 0u;
    if (bx == 0) { for (int i = tid; i < XCD_BAR_WORDS; i += NWAVES * 64) __hip_atomic_store(barw + i, 0u, __ATOMIC_RELAXED, __HIP_MEMORY_SCOPE_AGENT);
        for (int i = tid; i < 5 * 64; i += NWAVES * 64) __hip_atomic_store((unsigned*)(args.ws + WS_CTL) + CW_CNT + (i / 64) * 4096 + 64 * (i % 64), 0u, __ATOMIC_RELAXED, __HIP_MEMORY_SCOPE_AGENT);
        if (tid == 0) __hip_atomic_store((unsigned*)(args.ws + WS_CTL) + 2, 0u, __ATOMIC_RELAXED, __HIP_MEMORY_SCOPE_AGENT); } }
    __syncthreads();
#define IN(i) ldptr(PT, (i))
    unsigned char* ws = args.ws;
    const float* x = args.in[0];
    float* out = args.out;
    bf16_t* Hb = (bf16_t*)(ws + WS_H);
    LAS float* scr = (LAS float*)(lds + wave * 16384);
    CG_SYNC();
    const XcdBarrier xbar = xcd_barrier_post(barw, MISC + 8);

    {
        FRESH();
        if (bx == 0 && tid == 0) { atomicExch((unsigned*)(ws + WS_CTL), 0u); atomicExch((unsigned*)(ws + WS_CTL) + 64, 0u); }
        constexpr int NIT = 2 * 1408 + 512 + 1024 + 16 * 8;
        for (int it = gw; it < NIT; it += NGW) {
            int r = it;
            CONV(IN(3), 1024, DFF, (bf16_t*)(ws + WS_WGU), 1, 0);
            CONV(IN(4), 1024, DFF, (bf16_t*)(ws + WS_WGU), 1, 128);
            CONV(IN(28), 1024, 1024, (bf16_t*)(ws + WS_WMIX), 0, 0);
            CONV(IN(24), 1024, 2048, (bf16_t*)(ws + WS_WKV), 0, 0);
            if (r >= 0) { const int mat = r >> 3, sub = r & 7; const float* src = (mat < 8 ? IN(17) + (size_t)mat * 16384 : IN(19) + (size_t)(mat - 8) * 16384);
              transpose_item(src, 128, 128, (bf16_t*)(ws + WS_WLRU) + (size_t)mat * 16384, 0, 0, scr, sub, lane); }
        }
        { int m = gw;
          for (; m + 3 * NGW < T; m += 4 * NGW) rms_row4_to_bf16(x + (size_t)m * D, (size_t)NGW * D, IN(2), Hb + (size_t)m * D, lane);
          for (; m + NGW < T; m += 2 * NGW) rms_row2_to_bf16(x + (size_t)m * D, x + (size_t)(m + NGW) * D, IN(2), Hb + (size_t)m * D, Hb + (size_t)(m + NGW) * D, lane);
          if (m < T) rms_row_to_bf16(x + (size_t)m * D, IN(2), Hb + (size_t)m * D, lane); }
        for (int m = gw; m < NB * NMEM; m += NGW) rms_row_to_bf16(IN(1) + (size_t)m * D, IN(23), (bf16_t*)(ws + WS_MEMN) + (size_t)m * D, lane);
    }
    GRID_SYNC();


    {
        pg8::SchedTwo S{(const char*)Hb, (const char*)(ws + WS_WGU), (const char*)(ws + WS_MEMN), (const char*)(ws + WS_WKV), 1024, 64, 22, 8, 8, G, bx};
        pg8::EpiSwigluKv E{(bf16_t*)(ws + WS_ACT1), (bf16_t*)(ws + WS_KVM), 2048};
        pg8::gemm_phase(lds, 1024, S, E);
        const int nfull = (64 * 22 + 64) % G;
        const int nhelp = (nfull == 0) ? G : G - nfull, hidx = (nfull == 0) ? bx : bx - nfull;
        if (hidx >= 0) {
            FRESH();
            constexpr int NIT = 1408 + 3072;
            for (int it = hidx * NWAVES + wave; it < NIT; it += nhelp * NWAVES) {
                int r = it;
                CONV(IN(5), DFF, 1024, (bf16_t*)(ws + WS_WD), 0, 0);
                if (r >= 0) transpose_item(IN(8), 1024, 6144, (bf16_t*)(ws + WS_WIN), 0, 0, scr, r, lane);
            }
        }
    }
    GRID_SYNC();
    {
        unsigned* ctl = (unsigned*)(ws + WS_CTL);
        pg8::SchedPlain S{(const char*)(ws + WS_ACT1), (const char*)(ws + WS_WD), DFF, 64, 4, G, bx};
        pg8::RmsExchange st1{(unsigned*)(ws + WS_XSLOT), ctl + CW_CNT + 0 * 4096, ctl + 2}, st2{(unsigned*)(ws + WS_XSLOT) + 65536, ctl + CW_CNT + 1 * 4096, ctl + 2};
        pg8::EpiRmsRes<true> E{x, out, Hb, IN(6), IN(7), 0.5f, st1, st2};
        pg8::gemm_phase(lds, DFF, S, E);
    }
    GRID_SYNC();
    {
        pg8::SchedPlain S{(const char*)Hb, (const char*)(ws + WS_WIN), 1024, 64, 24, G, bx};
        pg8::EpiSplitBf16 E{(bf16_t*)(ws + WS_SQ), (size_t)T * 1024};
        pg8::gemm_phase(lds, 1024, S, E);
    }
    GRID_SYNC();
    {
        FRESH();
        constexpr int NIT = 3 * 512 + 1536;
        for (int it = gw; it < NIT; it += NGW) {
            int r = it;
            CONV(IN(14), 1024, 1024, (bf16_t*)(ws + WS_W3), 0, 0);
            CONV(IN(22), 1024, 1024, (bf16_t*)(ws + WS_W3), 0, 1024);
            CONV(IN(25), 1024, 1024, (bf16_t*)(ws + WS_W3), 0, 2048);
            if (r >= 0) transpose_item(IN(26), 1024, 3072, (bf16_t*)(ws + WS_WBG), 0, 0, scr, r, lane);
        }
        float lamv;
        { float s1 = 0.f, s2 = 0.f;
          s1 = wave_sum(IN(9)[lane] * IN(10)[lane]); s2 = wave_sum(IN(11)[lane] * IN(12)[lane]);
          lamv = __uint_as_float(__builtin_amdgcn_readfirstlane(__float_as_uint(expf(s1) - expf(s2) + 0.2f))); }
        unsigned* ctr = (unsigned*)(ws + WS_CTL);
        constexpr int NU_LRU = 64, NU_DA = 1024, NU_CA = 512, NU = NU_LRU + NU_DA;
        for (;;) {
            __syncthreads();
            if (threadIdx.x == 0) MISC[0] = atomicAdd(ctr, 1u);
            __syncthreads();
            const unsigned uu = MISC[0];
            if (uu >= (unsigned)NU) break;
            const int u = (int)uu;
            if (u < NU_LRU) {
                lru_unit<true>(lds, u >> 3, u & 7, (const bf16_t*)(ws + WS_SX), (bf16_t*)(ws + WS_SY), (const bf16_t*)(ws + WS_WLRU), IN(15), IN(16), IN(18), IN(20), IN(21));
            } else {
                const int j = u - NU_LRU, qb = 15 - (j >> 6), bh = j & 63, b = bh >> 3, h = bh & 7;
                const size_t rowb = (size_t)b * SEQ;
                bf16_t* Q = (bf16_t*)(ws + WS_SQ) + (rowb + 128 * qb) * 1024 + h * 128;
                const bf16_t* Kp = (const bf16_t*)(ws + WS_SK) + rowb * 1024 + h * 128;
                const bf16_t* Vp = (const bf16_t*)(ws + WS_SV) + rowb * 1024 + h * 128;
                const float slope = exp2f(-(float)(h + 1));
                attn_unit<2, 64, 128, true>(lds, Q, Kp, 1024, Vp, 1024, Q, 1024, 128 * qb, 2 * (qb + 1), 0.125f * LOG2E, slope * LOG2E, lamv, IN(13));
            }
        }
        for (;;) {
            __syncthreads();
            if (threadIdx.x == 0) MISC[0] = atomicAdd(ctr + 64, 1u);
            __syncthreads();
            const unsigned uu = MISC[0];
            if (uu >= (unsigned)NU_CA) break;
            {
                const int j = (int)uu, qb = j >> 5, bh = j & 31, b = bh >> 2, h = bh & 3;
                bf16_t* Q = (bf16_t*)(ws + WS_SQC) + ((size_t)b * SEQ + 128 * qb) * 1024 + h * 256;
                const bf16_t* Kp = (const bf16_t*)(ws + WS_KVM) + (size_t)b * NMEM * 2048 + h * 256;
                const bf16_t* Vp = Kp + 1024;
                attn_unit<1, 256, 256, false>(lds, Q, Kp, 2048, Vp, 2048, Q, 1024, 0, 4, 0.0625f * LOG2E, 0.f, 0.f, IN(13));
            }
        }
    }
    GRID_SYNC();
    {
        pg8::SchedMerge S{(const char*)Hb, (const char*)(ws + WS_WBG), (const char*)(ws + WS_SQ), (const char*)(ws + WS_SY), (const char*)(ws + WS_SQC), (const char*)(ws + WS_W3), G, bx};
        pg8::EpiMerge E{(u32x4*)(ws + WS_GSCR) + (size_t)bx * 16 * 512, IN(27), (bf16_t*)(ws + WS_MERGED)};
        pg8::gemm_phase(lds, 1024, S, E);
    }
    GRID_SYNC();
    {
        {
            FRESH();
            constexpr int NIT = 3 * 1408;
            for (int it = gw; it < NIT; it += NGW) {
                int r = it;
                CONV(IN(31), 1024, DFF, (bf16_t*)(ws + WS_WGU), 1, 0);
                CONV(IN(32), 1024, DFF, (bf16_t*)(ws + WS_WGU), 1, 128);
                if (r >= 0) transpose_item(IN(33), DFF, 1024, (bf16_t*)(ws + WS_WD), 0, 0, scr, r, lane);
            }
            __syncthreads();
        }
        unsigned* ctl = (unsigned*)(ws + WS_CTL);
        pg8::SchedPlain S{(const char*)(ws + WS_MERGED), (const char*)(ws + WS_WMIX), 1024, 64, 4, G, bx};
        pg8::RmsExchange st1{(unsigned*)(ws + WS_XSLOT), ctl + CW_CNT + 2 * 4096, ctl + 2}, st2{(unsigned*)(ws + WS_XSLOT) + 65536, ctl + CW_CNT + 3 * 4096, ctl + 2};
        pg8::EpiRmsRes<true> E{out, out, Hb, IN(29), IN(30), 1.0f, st1, st2};
        pg8::gemm_phase(lds, 1024, S, E);
    }
    GRID_SYNC();
    {
        pg8::SchedTwo S{(const char*)Hb, (const char*)(ws + WS_WGU), (const char*)Hb, (const char*)(ws + WS_WGU), 1024, 64, 22, 0, 0, G, bx};
        pg8::EpiSwigluKv E{(bf16_t*)(ws + WS_ACT2), (bf16_t*)(ws + WS_ACT2), 2048};
        pg8::gemm_phase(lds, 1024, S, E);
    }
    GRID_SYNC();
    {
        unsigned* ctl = (unsigned*)(ws + WS_CTL);
        pg8::SchedPlain S{(const char*)(ws + WS_ACT2), (const char*)(ws + WS_WD), DFF, 64, 4, G, bx};
        pg8::RmsExchange st1{(unsigned*)(ws + WS_XSLOT), ctl + CW_CNT + 4 * 4096, ctl + 2};
        pg8::EpiRmsRes<false> E{out, out, nullptr, IN(34), nullptr, 0.5f, st1, st1};
        pg8::gemm_phase(lds, DFF, S, E);
    }
}

extern "C" void kernel_launch(void* const* d_in, const int* in_sizes, int n_in, void* d_out, int out_size, void* d_ws, size_t ws_size, hipStream_t stream) {
    static int grid = 0;
    if (grid == 0) {
        if (n_in != 35 || ws_size < WS_END) { fprintf(stderr, "kernel_launch: unexpected inputs (n_in %d, ws %zu)\n", n_in, ws_size); grid = -1; return; }
        int dev = 0, cus = 0, per_cu = 0;
        hipGetDevice(&dev);
        hipDeviceGetAttribute(&cus, hipDeviceAttributeMultiprocessorCount, dev);
        hipFuncSetAttribute((const void*)fwd_megakernel, hipFuncAttributeMaxDynamicSharedMemorySize, LDS_BYTES);
        hipOccupancyMaxActiveBlocksPerMultiprocessor(&per_cu, (const void*)fwd_megakernel, NWAVES * 64, LDS_BYTES);
        if (per_cu < 1) per_cu = 1;
        grid = cus > 256 ? 256 : cus;
        (void)hipGetLastError();
    }
    if (grid < 0) return;
    Args a{};
    for (int i = 0; i < 35; ++i) a.in[i] = (const float*)d_in[i];
    a.out = (float*)d_out; a.ws = (unsigned char*)d_ws;
    void* kargs[] = {&a};
    hipError_t e = hipLaunchCooperativeKernel((const void*)fwd_megakernel, dim3(grid), dim3(NWAVES * 64), kargs, LDS_BYTES, stream);
    if (e != hipSuccess) fprintf(stderr, "cooperative launch failed: %s (grid %d)\n", hipGetErrorString(e), grid);
}
```
